# Optimizing an MI355X kernel written in HIP

```python
import math
import jax, jax.numpy as jnp
from jax import lax
import numpy as np


D_MODEL = 1024
BATCH = 4
SEQ = 8192
DEPTH = 2

CHUNK = 64
CONV_WIDTH = 4
RMS_EPS = 1e-6
GDN_HEADS = D_MODEL // 256
GDN_DK = 128
GDN_DV = 128
GDN_QK = GDN_HEADS * GDN_DK
GDN_V = GDN_HEADS * GDN_DV
SSD_HEADDIM = 64
SSD_HEADS = D_MODEL // 128
SSD_INNER = SSD_HEADS * SSD_HEADDIM
SSD_GROUPS = 2
SSD_STATE = 128
SSD_BC = SSD_GROUPS * SSD_STATE
LRU_WIDTH = D_MODEL // 2
LRU_BLOCKS = 8
LRU_BLOCK = LRU_WIDTH // LRU_BLOCKS
LRU_C = 8.0
N_BRANCH = 3
BRANCH_WIDTH = 512
D_FF = 4 * D_MODEL
N_MOD = 6
IN_SPLITS = (GDN_QK, GDN_QK, GDN_V, GDN_V, GDN_HEADS, GDN_HEADS,
             SSD_INNER, SSD_INNER, SSD_BC, SSD_BC, SSD_HEADS,
             LRU_WIDTH, LRU_WIDTH,
             N_BRANCH * D_MODEL)
D_IN = sum(IN_SPLITS)

kernel_name = 'hybrid_gdn_ssd_rglru_adaln_block'


def rmsnorm(x, w):
    xf = x.astype(jnp.float32)
    y = xf * lax.rsqrt(jnp.mean(xf * xf, axis=-1, keepdims=True) + RMS_EPS)
    return (y * w.astype(jnp.float32)).astype(x.dtype)


def l2norm(x):
    return x * lax.rsqrt(jnp.sum(x * x, axis=-1, keepdims=True) + RMS_EPS)


def split_cols(t, sizes):
    idx = np.cumsum(sizes)[:-1].tolist()
    return jnp.split(t, idx, axis=-1)


def causal_conv(x, w):
    width = w.shape[0]
    seq = x.shape[1]
    xp = jnp.pad(x, ((0, 0), (width - 1, 0), (0, 0)))
    return sum(xp[:, k:k + seq] * w[k] for k in range(width))


def gated_deltanet(q, k, v, z, b_raw, a_raw, a_log, dt_bias, norm_w):
    f32 = jnp.float32
    bsz, seq, _ = q.shape
    nc = seq // CHUNK

    def heads(t, d):
        return t.astype(f32).reshape(bsz, nc, CHUNK, GDN_HEADS, d).transpose(0, 1, 3, 2, 4)

    def per_head(t):
        return t.astype(f32).reshape(bsz, nc, CHUNK, GDN_HEADS).transpose(0, 1, 3, 2)

    q = l2norm(heads(q, GDN_DK)) * (GDN_DK ** -0.5)
    k = l2norm(heads(k, GDN_DK))
    v = heads(v, GDN_DV)
    beta = jax.nn.sigmoid(per_head(b_raw))
    g = -jnp.exp(a_log.astype(f32))[:, None] * jax.nn.softplus(per_head(a_raw) + dt_bias.astype(f32)[:, None])
    gcum = jnp.cumsum(g, axis=-1)
    causal = jnp.tril(jnp.ones((CHUNK, CHUNK), bool))
    strict = jnp.tril(jnp.ones((CHUNK, CHUNK), bool), -1)
    decay = jnp.exp(jnp.where(causal, gcum[..., :, None] - gcum[..., None, :], -jnp.inf))
    kk = jnp.einsum('bnhcd,bnhed->bnhce', k, k)
    m = jnp.where(strict, beta[..., :, None] * kk * decay, 0.0)
    eye = jnp.eye(CHUNK, dtype=f32)
    rhs = jnp.concatenate([beta[..., None] * v, (beta * jnp.exp(gcum))[..., None] * k], axis=-1)
    sol = lax.linalg.triangular_solve(eye + m, rhs, left_side=True, lower=True, unit_diagonal=True)
    u, w = sol[..., :GDN_DV], sol[..., GDN_DV:]
    qk = jnp.einsum('bnhcd,bnhed->bnhce', q, k) * decay
    q_dec = q * jnp.exp(gcum)[..., None]
    k_dec = k * jnp.exp(gcum[..., -1:] - gcum)[..., None]
    g_tot = jnp.exp(gcum[..., -1])

    def step(state, inp):
        u_c, w_c, qk_c, qd_c, kd_c, gt_c = inp
        v_new = u_c - jnp.einsum('bhck,bhkv->bhcv', w_c, state)
        o_c = jnp.einsum('bhck,bhkv->bhcv', qd_c, state) + jnp.einsum('bhce,bhev->bhcv', qk_c, v_new)
        state = state * gt_c[..., None, None] + jnp.einsum('bhck,bhcv->bhkv', kd_c, v_new)
        return state, o_c

    xs = tuple(jnp.moveaxis(t, 1, 0) for t in (u, w, qk, q_dec, k_dec, g_tot))
    s0 = jnp.zeros((bsz, GDN_HEADS, GDN_DK, GDN_DV), f32)
    _, o = lax.scan(step, s0, xs)
    o = o.transpose(1, 0, 3, 2, 4).reshape(bsz, seq, GDN_HEADS, GDN_DV)
    zh = z.astype(f32).reshape(bsz, seq, GDN_HEADS, GDN_DV)
    o = rmsnorm(o, norm_w) * jax.nn.silu(zh)
    return o.reshape(bsz, seq, GDN_V)


def ssd_scan(xs, bm, cm, dt_raw, a_log, dt_bias, d_skip):
    f32 = jnp.float32
    bsz, seq, _ = xs.shape
    nc = seq // CHUNK
    hpg = SSD_HEADS // SSD_GROUPS
    x = xs.astype(f32).reshape(bsz, nc, CHUNK, SSD_GROUPS, hpg, SSD_HEADDIM)
    bm = bm.astype(f32).reshape(bsz, nc, CHUNK, SSD_GROUPS, SSD_STATE)
    cm = cm.astype(f32).reshape(bsz, nc, CHUNK, SSD_GROUPS, SSD_STATE)
    dt = jax.nn.softplus(dt_raw.astype(f32) + dt_bias.astype(f32)).reshape(bsz, nc, CHUNK, SSD_GROUPS, hpg)
    a = -jnp.exp(a_log.astype(f32)).reshape(SSD_GROUPS, hpg)
    acum = jnp.cumsum(dt * a, axis=2)
    xdt = x * dt[..., None]
    causal = jnp.tril(jnp.ones((CHUNK, CHUNK), bool))
    seg = acum[:, :, :, None] - acum[:, :, None, :]
    lmat = jnp.exp(jnp.where(causal[:, :, None, None], seg, -jnp.inf))
    cb = jnp.einsum('bncgs,bnegs->bnceg', cm, bm)
    y_diag = jnp.einsum('bnceg,bncegh,bneghp->bncghp', cb, lmat, xdt)
    decay_end = jnp.exp(acum[:, :, -1:] - acum)
    chunk_states = jnp.einsum('bncgs,bncgh,bncghp->bnghps', bm, decay_end, xdt)
    chunk_decay = jnp.exp(acum[:, :, -1])

    def step(state, inp):
        st, dc = inp
        return state * dc[..., None, None] + st, state

    s0 = jnp.zeros((bsz, SSD_GROUPS, hpg, SSD_HEADDIM, SSD_STATE), f32)
    _, prev = lax.scan(step, s0, (jnp.moveaxis(chunk_states, 1, 0), jnp.moveaxis(chunk_decay, 1, 0)))
    prev = jnp.moveaxis(prev, 0, 1)
    y_off = jnp.einsum('bncgs,bnghps,bncgh->bncghp', cm, prev, jnp.exp(acum))
    y = y_diag + y_off + d_skip.astype(f32).reshape(SSD_GROUPS, hpg)[:, :, None] * x
    return y.reshape(bsz, seq, SSD_INNER)


def rg_lru(x, w_a, b_a, w_x, b_x, lam):
    f32 = jnp.float32
    bsz, seq, _ = x.shape
    xf = x.astype(f32)
    xb = xf.reshape(bsz, seq, LRU_BLOCKS, LRU_BLOCK)
    r = jax.nn.sigmoid(jnp.einsum('bsnd,nde->bsne', xb, w_a.astype(f32)).reshape(bsz, seq, LRU_WIDTH) + b_a.astype(f32))
    i = jax.nn.sigmoid(jnp.einsum('bsnd,nde->bsne', xb, w_x.astype(f32)).reshape(bsz, seq, LRU_WIDTH) + b_x.astype(f32))
    log_a = -LRU_C * r * jax.nn.softplus(-lam.astype(f32))
    a = jnp.exp(log_a)
    u = jnp.sqrt(-jnp.expm1(2.0 * log_a)) * (i * xf)

    def combine(left, right):
        a_l, u_l = left
        a_r, u_r = right
        return a_l * a_r, a_r * u_l + u_r

    _, hs = lax.associative_scan(combine, (a, u), axis=1)
    return hs


def hybrid_mixer(h, w_in, gdn_conv_w, gdn_a_log, gdn_dt_bias, gdn_norm,
                 ssd_conv_w, ssd_conv_b, ssd_a_log, ssd_dt_bias, ssd_d, ssd_norm,
                 lru_conv_w, lru_conv_b, lru_w_a, lru_b_a, lru_w_x, lru_b_x, lru_lambda,
                 w_branch, w_out):
    bsz, seq, _ = h.shape
    f32 = jnp.float32
    proj = h @ w_in
    (q, k, v, gdn_z, gdn_b, gdn_a, ssd_x, ssd_z, ssd_bm, ssd_cm, ssd_dt,
     lru_x, lru_gate, gate_logits) = split_cols(proj, IN_SPLITS)
    qkv = jax.nn.silu(causal_conv(jnp.concatenate([q, k, v], axis=-1), gdn_conv_w))
    q, k, v = split_cols(qkv, (GDN_QK, GDN_QK, GDN_V))
    y_a = gated_deltanet(q, k, v, gdn_z, gdn_b, gdn_a, gdn_a_log, gdn_dt_bias, gdn_norm)
    xbc = jax.nn.silu(causal_conv(jnp.concatenate([ssd_x, ssd_bm, ssd_cm], axis=-1), ssd_conv_w) + ssd_conv_b)
    sx, sb, sc = split_cols(xbc, (SSD_INNER, SSD_BC, SSD_BC))
    y = ssd_scan(sx, sb, sc, ssd_dt, ssd_a_log, ssd_dt_bias, ssd_d)
    gz = (y * jax.nn.silu(ssd_z.astype(f32))).reshape(bsz, seq, SSD_GROUPS, SSD_INNER // SSD_GROUPS)
    y_b = rmsnorm(gz, ssd_norm.reshape(SSD_GROUPS, SSD_INNER // SSD_GROUPS)).reshape(bsz, seq, SSD_INNER)
    xc = causal_conv(lru_x, lru_conv_w) + lru_conv_b
    y_c = rg_lru(xc, lru_w_a, lru_b_a, lru_w_x, lru_b_x, lru_lambda) * jax.nn.gelu(lru_gate.astype(f32))
    gates = jax.nn.sigmoid(gate_logits.reshape(bsz, seq, N_BRANCH, D_MODEL))
    merged = sum(gates[:, :, r] * (y_r.astype(h.dtype) @ w_branch[r]) for r, y_r in enumerate((y_a, y_b, y_c)))
    return merged @ w_out


def setup_inputs(seed: int = 0) -> dict:
    key = jax.random.key(seed)
    ks = iter(jax.random.split(key, 40))
    L = DEPTH

    def nrm(shape, scale):
        return jax.random.normal(next(ks), shape, jnp.float32) * scale

    def gain(shape):
        return 1.0 + nrm(shape, 0.1)

    def dt_bias_init(n):
        dt = jnp.exp(jax.random.uniform(next(ks), (L, n), jnp.float32, math.log(1e-3), math.log(1e-1)))
        return dt + jnp.log(-jnp.expm1(-dt))

    def a_log_init(n):
        return jnp.log(jax.random.uniform(next(ks), (L, n), jnp.float32, 1.0, 16.0))

    x = nrm((BATCH, SEQ, D_MODEL), 1.0)
    c = nrm((BATCH, D_MODEL), 1.0)
    ada_w = nrm((L, D_MODEL, N_MOD * D_MODEL), 0.3 * D_MODEL ** -0.5)
    ada_b = nrm((L, N_MOD * D_MODEL), 0.02)
    norm_mix = gain((L, D_MODEL))
    w_in = nrm((L, D_MODEL, D_IN), D_MODEL ** -0.5)
    gdn_conv_w = nrm((L, CONV_WIDTH, 2 * GDN_QK + GDN_V), CONV_WIDTH ** -0.5)
    gdn_a_log = a_log_init(GDN_HEADS)
    gdn_dt_bias = dt_bias_init(GDN_HEADS)
    gdn_norm = gain((L, GDN_DV))
    ssd_conv_w = nrm((L, CONV_WIDTH, SSD_INNER + 2 * SSD_BC), CONV_WIDTH ** -0.5)
    ssd_conv_b = nrm((L, SSD_INNER + 2 * SSD_BC), 0.02)
    ssd_a_log = a_log_init(SSD_HEADS)
    ssd_dt_bias = dt_bias_init(SSD_HEADS)
    ssd_d = gain((L, SSD_HEADS))
    ssd_norm = gain((L, SSD_INNER))
    lru_conv_w = nrm((L, CONV_WIDTH, LRU_WIDTH), CONV_WIDTH ** -0.5)
    lru_conv_b = nrm((L, LRU_WIDTH), 0.02)
    lru_w_a = nrm((L, LRU_BLOCKS, LRU_BLOCK, LRU_BLOCK), LRU_BLOCK ** -0.5)
    lru_b_a = nrm((L, LRU_WIDTH), 0.02)
    lru_w_x = nrm((L, LRU_BLOCKS, LRU_BLOCK, LRU_BLOCK), LRU_BLOCK ** -0.5)
    lru_b_x = nrm((L, LRU_WIDTH), 0.02)
    a_pow = jax.random.uniform(next(ks), (L, LRU_WIDTH), jnp.float32, 0.9, 0.999)
    s = a_pow ** (1.0 / LRU_C)
    lru_lambda = jnp.log(s) - jnp.log1p(-s)
    w_branch = nrm((L, N_BRANCH, BRANCH_WIDTH, D_MODEL), BRANCH_WIDTH ** -0.5)
    w_out = nrm((L, D_MODEL, D_MODEL), D_MODEL ** -0.5)
    norm_mlp = gain((L, D_MODEL))
    w_up = nrm((L, D_MODEL, D_FF), D_MODEL ** -0.5)
    w_down = nrm((L, D_FF, D_MODEL), D_FF ** -0.5)
    final_norm = gain((D_MODEL,))
    return {'x': x, 'c': c, 'ada_w': ada_w, 'ada_b': ada_b, 'norm_mix': norm_mix, 'w_in': w_in,
            'gdn_conv_w': gdn_conv_w, 'gdn_a_log': gdn_a_log, 'gdn_dt_bias': gdn_dt_bias, 'gdn_norm': gdn_norm,
            'ssd_conv_w': ssd_conv_w, 'ssd_conv_b': ssd_conv_b, 'ssd_a_log': ssd_a_log, 'ssd_dt_bias': ssd_dt_bias,
            'ssd_d': ssd_d, 'ssd_norm': ssd_norm,
            'lru_conv_w': lru_conv_w, 'lru_conv_b': lru_conv_b, 'lru_w_a': lru_w_a, 'lru_b_a': lru_b_a,
            'lru_w_x': lru_w_x, 'lru_b_x': lru_b_x, 'lru_lambda': lru_lambda,
            'w_branch': w_branch, 'w_out': w_out, 'norm_mlp': norm_mlp, 'w_up': w_up, 'w_down': w_down,
            'final_norm': final_norm}


def reference(x, c, ada_w, ada_b, norm_mix, w_in, gdn_conv_w, gdn_a_log, gdn_dt_bias, gdn_norm,
              ssd_conv_w, ssd_conv_b, ssd_a_log, ssd_dt_bias, ssd_d, ssd_norm,
              lru_conv_w, lru_conv_b, lru_w_a, lru_b_a, lru_w_x, lru_b_x, lru_lambda,
              w_branch, w_out, norm_mlp, w_up, w_down, final_norm):
    for l in range(DEPTH):
        mod = jax.nn.silu(c) @ ada_w[l] + ada_b[l]
        sh1, sc1, gt1, sh2, sc2, gt2 = jnp.split(mod[:, None, :], N_MOD, axis=-1)
        h = rmsnorm(x, norm_mix[l]) * (1 + sc1) + sh1
        mix = hybrid_mixer(h, w_in[l], gdn_conv_w[l], gdn_a_log[l], gdn_dt_bias[l], gdn_norm[l],
                           ssd_conv_w[l], ssd_conv_b[l], ssd_a_log[l], ssd_dt_bias[l], ssd_d[l], ssd_norm[l],
                           lru_conv_w[l], lru_conv_b[l], lru_w_a[l], lru_b_a[l], lru_w_x[l], lru_b_x[l],
                           lru_lambda[l], w_branch[l], w_out[l])
        x = x + gt1 * mix
        h = rmsnorm(x, norm_mlp[l]) * (1 + sc2) + sh2
        x = x + gt2 * (jnp.square(jax.nn.relu(h @ w_up[l])) @ w_down[l])
    return rmsnorm(x, final_norm)
```

```cpp
#include <hip/hip_runtime.h>
#include <hip/hip_cooperative_groups.h>
#include <cstdio>
#include <cstdint>
namespace cg = cooperative_groups;

#define LAS __attribute__((address_space(3)))
typedef unsigned short bf16_t;
typedef short bf16x8 __attribute__((ext_vector_type(8)));
typedef short s16x4 __attribute__((ext_vector_type(4)));
typedef float f32x4 __attribute__((ext_vector_type(4)));
typedef float f32x16 __attribute__((ext_vector_type(16)));
typedef unsigned u32x4 __attribute__((ext_vector_type(4)));
typedef unsigned u32x2 __attribute__((ext_vector_type(2)));
#define DI __device__ __forceinline__

#ifndef MK_SINGLE
#define MK_SINGLE 1
#endif

constexpr int DM = 1024, SEQ = 8192, MTOK = 32768, NPROJ = 4608, DFF = 4096, DIN = 7696;
constexpr int PC_Q = 0, PC_K = 512, PC_V = 1024, PC_GZ = 1536, PC_SX = 2048, PC_SZ = 2560, PC_BM = 3072, PC_CM = 3328, PC_LX = 3584, PC_LG = 4096;
constexpr size_t MiB = 1u << 20;
constexpr size_t WS_MOD = 0;
constexpr size_t WS_WSM = 256 * 1024;
constexpr size_t WS_GC = 1 * MiB;
constexpr size_t WS_LSEG = 1 * MiB + 512 * 1024;
constexpr size_t WS_LRUP = WS_LSEG + 4096;
constexpr size_t WS_LRUH = WS_LRUP + 128 * 1024;
constexpr size_t WS_SMALL = 2 * MiB;
constexpr size_t WS_TAIL = 4 * MiB;
constexpr size_t WS_W = 9 * MiB;
constexpr size_t WS_XN = 81 * MiB;
constexpr size_t WS_PROJ = 145 * MiB;
constexpr size_t WS_KDT = 433 * MiB;
constexpr size_t WS_QK = 465 * MiB;
constexpr size_t WS_SSEG = 481 * MiB;
constexpr size_t WS_MERGED = 433 * MiB;
constexpr size_t WS_END = 497 * MiB;
constexpr size_t WO_IN = 0, WO_GATE = 4718592, WO_BR = WO_GATE + 3145728, WO_OUT = WO_BR + 1572864, WO_UP = WO_OUT + 1048576, WO_DOWN = WO_UP + 4194304, WO_LAYER = WO_DOWN + 4194304;
constexpr int LDS_BYTES = 147456;

DI unsigned f2bf(float f) { unsigned u = __builtin_bit_cast(unsigned, f); return (u + 0x7fffu + ((u >> 16) & 1u)) >> 16; }
DI unsigned pk2(float lo, float hi) { return f2bf(lo) | (f2bf(hi) << 16); }
DI float bf2f(unsigned short v) { return __builtin_bit_cast(float, (unsigned)v << 16); }
DI float bflo(unsigned v) { return __builtin_bit_cast(float, v << 16); }
DI float bfhi(unsigned v) { return __builtin_bit_cast(float, v & 0xffff0000u); }
DI float sigmoid_f(float x) { return 1.f / (1.f + __expf(-x)); }
DI float silu_f(float x) { return x / (1.f + __expf(-x)); }
DI float softplus_f(float x) { return fmaxf(x, 0.f) + log1pf(__expf(-fabsf(x))); }
DI float gelu_tanh_f(float x) { const float u = 0.7978845608028654f * (x + 0.044715f * x * x * x); const float t = 1.f - 2.f / (1.f + __expf(2.f * u)); return 0.5f * x * (1.f + t); }
DI float wave_sum(float v) {
#pragma unroll
    for (int o = 1; o < 64; o <<= 1) v += __shfl_xor(v, o);
    return v;
}
DI float wave_incl_scan(float v, int lane) {
#pragma unroll
    for (int o = 1; o < 64; o <<= 1) { const float t = __shfl_up(v, o); if (lane >= o) v += t; }
    return v;
}
DI bf16x8 pack8(float a0, float a1, float a2, float a3, float a4, float a5, float a6, float a7) {
    u32x4 p; p.x = pk2(a0, a1); p.y = pk2(a2, a3); p.z = pk2(a4, a5); p.w = pk2(a6, a7); return __builtin_bit_cast(bf16x8, p);
}
DI bf16x8 cat4(s16x4 lo, s16x4 hi) { return __builtin_shufflevector(lo, hi, 0, 1, 2, 3, 4, 5, 6, 7); }
#define MFMA16(a, b, c) __builtin_amdgcn_mfma_f32_16x16x32_bf16((a), (b), (c), 0, 0, 0)
#define MFMA32(a, b, c) __builtin_amdgcn_mfma_f32_32x32x16_bf16((a), (b), (c), 0, 0, 0)
DI bf16x8 ldfrag(const LAS bf16_t* base, int pitch, int row, int k0) { return *(const LAS bf16x8*)(base + row * pitch + k0); }
DI bf16x8 ldfrag_perm16(const LAS bf16_t* base, int pitch, int row, int s, int q) {
    const LAS bf16_t* p = base + row * pitch + 32 * s + 4 * q; return cat4(*(const LAS s16x4*)p, *(const LAS s16x4*)(p + 16));
}
DI s16x4 ldg8(const void* base, unsigned off) { return *(const s16x4*)((const char*)base + off); }
DI bf16x8 ldg8x2(const void* base, unsigned off) { return cat4(ldg8(base, off), ldg8(base, off + 16u)); }
DI int crow(int r, int hh) { return (r & 3) + 8 * (r >> 2) + 4 * hh; }

struct Ctx { LAS unsigned char* lds; int tid, lane, wave, G, bid; };
DI Ctx make_ctx(LAS unsigned char* lds) { Ctx F; int t = threadIdx.x; asm volatile("" : "+v"(t)); F.lds = lds; F.tid = t; F.lane = t & 63; F.wave = __builtin_amdgcn_readfirstlane(t >> 6); F.G = gridDim.x; F.bid = blockIdx.x; return F; }
struct Args { const float* in[29]; float* out; unsigned char* ws; int ph_lo, ph_hi; };

namespace pg8 {
constexpr int BM = 256, BK = 64, HALF = 128, HTB = HALF * BK * 2, STAGE_BYTES = 8 * HTB, NXCD = 8, WGM = 8;
DI int lds_byte(int r, int c) { const int st = (r >> 4) * 2 + (c >> 5), rr = r & 15, cc = c & 31, ob = rr * 64 + cc * 2; return st * 1024 + (ob ^ (((ob >> 9) & 1) << 5)); }
DI void stage_rc(int b, int& R, int& C) { const int st = b / 1024, sb = b % 1024, swz = sb ^ (((sb >> 9) & 1) << 5); R = (st >> 1) * 16 + swz / 64; C = (st & 1) * 32 + (swz % 64) / 2; }
struct Unit { int pm, pn; };
struct Gemm { const bf16_t* A; const bf16_t* Bt; int M, N, K, lda, ldb; };
struct StaticOrder {
    int nM, nN, nwg, G, c;
    DI void init(int M, int N, int G_, int c_) { nM = M / BM; nN = N / BM; nwg = nM * nN; G = G_; c = c_; }
    DI bool next(int i, Unit& u) const {
        const long L = (long)i * G + c; if (L >= nwg) return false;
        int wgid = (int)L; { const int q = nwg / NXCD, r = nwg % NXCD, xcd = wgid % NXCD, off = wgid / NXCD; wgid = (xcd < r ? xcd * (q + 1) : r * (q + 1) + (xcd - r) * q) + off; }
        const int nig = WGM * nN, gid = wgid / nig, fm = gid * WGM, gsz = (nM - fm) < WGM ? (nM - fm) : WGM;
        u.pm = fm + ((wgid % nig) % gsz); u.pn = (wgid % nig) / gsz; return true;
    }
};
template <class Epi>
DI void gemm_phase(LAS unsigned char* lds, const Gemm g, const StaticOrder& S, const Epi& E) {
    int tid_ = threadIdx.x; asm volatile("" : "+v"(tid_)); const int tid = tid_, wid = __builtin_amdgcn_readfirstlane(tid >> 6), lane = tid & 63, wr = wid >> 2, wc = wid & 3, fr = lane & 15, fq = lane >> 4;
    const int K = g.K, nt = K / BK;
    unsigned voffA[2], voffB[2];
#pragma unroll
    for (int i = 0; i < 2; ++i) { int R, C; stage_rc(tid * 16 + i * 8192, R, C); voffA[i] = (unsigned)(R * g.lda + C) * 2u; voffB[i] = (unsigned)(R * g.ldb + C) * 2u; }
    const size_t kstep = (size_t)(BK * 2);
    const size_t hstepA = (size_t)HALF * g.lda * 2, hstepB = (size_t)HALF * g.ldb * 2;
    const size_t tstepA = 2 * hstepA, tstepB = 2 * hstepB;
    const unsigned ldsw = (unsigned)wid * 1024u;
    const int aoff = lds_byte(wr * 64 + fr, fq * 8), boff = lds_byte(wc * 32 + fr, fq * 8);
#define PG8_SA(b, h) (((b) * 2 + (h)) * HTB)
#define PG8_SB(b, h) ((4 + (b) * 2 + (h)) * HTB)
#define PG8_STAGE(bufoff, gbase, voff) do { _Pragma("unroll") for (int _i = 0; _i < 2; ++_i) \
        __builtin_amdgcn_global_load_lds((const unsigned*)((const char*)(gbase) + (voff)[_i]), (LAS unsigned*)(lds + (bufoff) + ldsw + _i * 8192), 16, 0, 0); } while (0)
#define PG8_LDA(dst, b, h) do { _Pragma("unroll") for (int m = 0; m < 4; ++m) _Pragma("unroll") for (int k = 0; k < 2; ++k) dst[m][k] = *(const LAS bf16x8*)(lds + PG8_SA(b, h) + aoff + m * 2048 + k * 1024); } while (0)
#define PG8_LDB(dst, b, h) do { _Pragma("unroll") for (int n = 0; n < 2; ++n) _Pragma("unroll") for (int k = 0; k < 2; ++k) dst[n][k] = *(const LAS bf16x8*)(lds + PG8_SB(b, h) + boff + n * 2048 + k * 1024); } while (0)
#define PG8_MMA(ai, bj, At, Bt) do { __builtin_amdgcn_s_setprio(1); _Pragma("unroll") for (int m = 0; m < 4; ++m) _Pragma("unroll") for (int n = 0; n < 2; ++n) _Pragma("unroll") for (int k = 0; k < 2; ++k) \
        acc[ai][bj][m][n] = __builtin_amdgcn_mfma_f32_16x16x32_bf16(Bt[n][k], At[m][k], acc[ai][bj][m][n], 0, 0, 0); __builtin_amdgcn_s_setprio(0); } while (0)
#define PG8_WAIT_V(n) asm volatile("s_waitcnt vmcnt(" #n ")" ::: "memory")
#define PG8_WAIT_L(n) asm volatile("s_waitcnt lgkmcnt(" #n ")" ::: "memory")
#define PG8_BAR __builtin_amdgcn_s_barrier()
#define PG8_SCHED __builtin_amdgcn_sched_barrier(0)
    Unit cur, nxt; int ui = 0;
    if (!S.next(0, cur)) return;
    f32x4 acc[2][2][4][2];
#pragma unroll
    for (int a = 0; a < 2; ++a)
#pragma unroll
        for (int b = 0; b < 2; ++b)
#pragma unroll
            for (int m = 0; m < 4; ++m)
#pragma unroll
                for (int n = 0; n < 2; ++n) acc[a][b][m][n] = (f32x4){0.f, 0.f, 0.f, 0.f};
    bf16x8 At[4][2], B0[2][2], B1[2][2];
    const char* cA = (const char*)g.A + (size_t)cur.pm * tstepA; const char* cB = (const char*)g.Bt + (size_t)cur.pn * tstepB;
    PG8_STAGE(PG8_SB(0, 0), cB, voffB); PG8_STAGE(PG8_SB(0, 1), cB + hstepB, voffB); PG8_STAGE(PG8_SA(0, 0), cA, voffA); PG8_STAGE(PG8_SA(0, 1), cA + hstepA, voffA);
    if (wr == 1) PG8_BAR;
    PG8_WAIT_V(2); PG8_BAR;
    PG8_STAGE(PG8_SB(1, 0), cB + kstep, voffB); PG8_STAGE(PG8_SA(1, 0), cA + kstep, voffA); PG8_STAGE(PG8_SB(1, 1), cB + hstepB + kstep, voffB);
    PG8_WAIT_V(6); PG8_BAR;
    for (;;) {
        const bool has_next = S.next(ui + 1, nxt);
        const char* nA = has_next ? (const char*)g.A + (size_t)nxt.pm * tstepA : cA; const char* nB = has_next ? (const char*)g.Bt + (size_t)nxt.pn * tstepB : cB;
        for (int t = 0; t < nt; t += 2) {
            const bool last = (t == nt - 2);
            const char* a1 = cA + (size_t)(t + 1) * kstep;
            const char* a2 = last ? nA : cA + (size_t)(t + 2) * kstep; const char* b2 = last ? nB : cB + (size_t)(t + 2) * kstep;
            const char* a3 = a2 + kstep; const char* b3 = b2 + kstep;
            PG8_LDB(B0, 0, 0); PG8_LDB(B1, 0, 1); PG8_SCHED; PG8_LDA(At, 0, 0); PG8_STAGE(PG8_SA(1, 1), a1 + hstepA, voffA);
            PG8_WAIT_V(8); PG8_WAIT_L(0); PG8_BAR; PG8_MMA(0, 0, At, B0); PG8_MMA(0, 1, At, B1); PG8_BAR; PG8_SCHED;
            PG8_LDA(At, 0, 1); PG8_STAGE(PG8_SB(0, 0), b2, voffB); PG8_STAGE(PG8_SB(0, 1), b2 + hstepB, voffB); PG8_STAGE(PG8_SA(0, 0), a2, voffA);
            PG8_WAIT_V(8); PG8_WAIT_L(0); PG8_BAR; PG8_MMA(1, 0, At, B0); PG8_MMA(1, 1, At, B1); PG8_BAR; PG8_SCHED;
            PG8_LDB(B0, 1, 0); PG8_LDB(B1, 1, 1); PG8_SCHED; PG8_LDA(At, 1, 0); PG8_STAGE(PG8_SA(0, 1), a2 + hstepA, voffA);
            PG8_WAIT_V(8); PG8_WAIT_L(0); PG8_BAR; PG8_MMA(0, 0, At, B0); PG8_MMA(0, 1, At, B1); PG8_BAR; PG8_SCHED;
            PG8_LDA(At, 1, 1); PG8_STAGE(PG8_SB(1, 0), b3, voffB); PG8_STAGE(PG8_SB(1, 1), b3 + hstepB, voffB); PG8_STAGE(PG8_SA(1, 0), a3, voffA);
            PG8_WAIT_V(8); PG8_WAIT_L(0); PG8_BAR; PG8_MMA(1, 0, At, B0); PG8_MMA(1, 1, At, B1); PG8_BAR; PG8_SCHED;
        }
        if (wr == 0) PG8_BAR;
        E(acc, cur, wr, wc, fr, fq);
        if (!has_next) break;
#pragma unroll
        for (int a = 0; a < 2; ++a)
#pragma unroll
            for (int b = 0; b < 2; ++b)
#pragma unroll
                for (int m = 0; m < 4; ++m)
#pragma unroll
                    for (int n = 0; n < 2; ++n) acc[a][b][m][n] = (f32x4){0.f, 0.f, 0.f, 0.f};
        cur = nxt; cA = nA; cB = nB; ++ui;
        if (wr == 1) PG8_BAR;
    }
    PG8_WAIT_V(0);
    PG8_BAR;
#undef PG8_SA
#undef PG8_SB
#undef PG8_STAGE
#undef PG8_LDA
#undef PG8_LDB
#undef PG8_MMA
#undef PG8_WAIT_V
#undef PG8_WAIT_L
#undef PG8_BAR
#undef PG8_SCHED
}
#define PG8_FOREACH(body) \
    _Pragma("unroll") for (int ai = 0; ai < 2; ++ai) _Pragma("unroll") for (int m = 0; m < 4; ++m) { const int row = u.pm * BM + ai * HALF + wr * 64 + m * 16 + fr; \
    _Pragma("unroll") for (int bj = 0; bj < 2; ++bj) _Pragma("unroll") for (int n = 0; n < 2; ++n) { const int col = u.pn * BM + bj * HALF + wc * 32 + n * 16 + 4 * fq; const f32x4 v = acc[ai][bj][m][n]; body } }

struct EpiProj {
    bf16_t* P; bf16_t* tail;
    DI void operator()(const f32x4 (&acc)[2][2][4][2], const Unit& u, int wr, int wc, int fr, int fq) const {
        PG8_FOREACH({ u32x2 w; w.x = pk2(v[0], v[1]); w.y = pk2(v[2], v[3]); *(u32x2*)(P + (size_t)row * NPROJ + col) = w;
            if (col < 1536 && (row & 63) >= 61) *(u32x2*)(tail + ((size_t)(row >> 6) * 3 + ((row & 63) - 61)) * 1536 + col) = w; })
    }
};
struct EpiGate {
    bf16_t* P; int ldc;
    DI void operator()(const f32x4 (&acc)[2][2][4][2], const Unit& u, int wr, int wc, int fr, int fq) const {
        PG8_FOREACH({ u32x2 w; w.x = pk2(sigmoid_f(v[0]), sigmoid_f(v[1])); w.y = pk2(sigmoid_f(v[2]), sigmoid_f(v[3])); *(u32x2*)(P + (size_t)row * ldc + col) = w; })
    }
};
template <bool FIRST> struct EpiBranch {
    const bf16_t* GT; int ldg; bf16_t* Mg;
    DI void operator()(const f32x4 (&acc)[2][2][4][2], const Unit& u, int wr, int wc, int fr, int fq) const {
        PG8_FOREACH({ const u32x2 gg = *(const u32x2*)(GT + (size_t)row * ldg + col); f32x4 o;
            o[0] = bflo(gg.x) * v[0]; o[1] = bfhi(gg.x) * v[1]; o[2] = bflo(gg.y) * v[2]; o[3] = bfhi(gg.y) * v[3];
            bf16_t* mp = Mg + (size_t)row * DM + col;
            if (!FIRST) { const u32x2 mm = *(const u32x2*)mp; o[0] += bflo(mm.x); o[1] += bfhi(mm.x); o[2] += bflo(mm.y); o[3] += bfhi(mm.y); }
            u32x2 w; w.x = pk2(o[0], o[1]); w.y = pk2(o[2], o[3]); *(u32x2*)mp = w; })
    }
};
struct EpiResid {
    const float* xin; float* xout; const float* gate;
    DI void operator()(const f32x4 (&acc)[2][2][4][2], const Unit& u, int wr, int wc, int fr, int fq) const {
        PG8_FOREACH({ const int b = row >> 13; const f32x4 gv = *(const f32x4*)(gate + b * 6144 + col); const f32x4 xv = *(const f32x4*)(xin + (size_t)row * DM + col);
            *(f32x4*)(xout + (size_t)row * DM + col) = xv + gv * v; })
    }
};
struct EpiUp {
    bf16_t* H;
    DI void operator()(const f32x4 (&acc)[2][2][4][2], const Unit& u, int wr, int wc, int fr, int fq) const {
        PG8_FOREACH({ f32x4 r; for (int e = 0; e < 4; ++e) { const float t = fmaxf(v[e], 0.f); r[e] = t * t; } u32x2 w; w.x = pk2(r[0], r[1]); w.y = pk2(r[2], r[3]); *(u32x2*)(H + (size_t)row * DFF + col) = w; })
    }
};
}

DI void p0_transpose_item(const float* W, int ldw, int col0, int K, bf16_t* WT, int row0, int nblk, LAS float* scr, int item, int lane) {
    const int kb = item / nblk, nb = item % nblk, k0 = 64 * kb, n0 = 32 * nb;
#pragma unroll 8
    for (int i = 0; i < 32; ++i) { const int kk = 2 * i + (lane >> 5); scr[kk * 33 + (lane & 31)] = W[(size_t)(k0 + kk) * ldw + col0 + n0 + (lane & 31)]; }
    asm volatile("s_waitcnt lgkmcnt(0)" ::: "memory");
    const int c = lane & 7;
#pragma unroll
    for (int j = 0; j < 4; ++j) { const int n = (lane >> 3) + 8 * j; const LAS float* s = scr + (8 * c) * 33 + n;
        u32x4 o; o.x = pk2(s[0 * 33], s[1 * 33]); o.y = pk2(s[2 * 33], s[3 * 33]); o.z = pk2(s[4 * 33], s[5 * 33]); o.w = pk2(s[6 * 33], s[7 * 33]);
        *(u32x4*)(WT + (size_t)(row0 + n0 + n) * K + k0 + 8 * c) = o; }
    asm volatile("s_waitcnt lgkmcnt(0)" ::: "memory");
}

DI void phase_p0(const Ctx& F, const Args& a) {
    unsigned char* ws = a.ws;
    float* MOD = (float*)(ws + WS_MOD);
    for (int it = F.bid; it < 192; it += F.G) {
        const int l = it / 96, cb = it % 96, col = cb * 64 + F.lane;
        const float* aw = a.in[2] + (size_t)l * DM * 6144; const float* cc = a.in[1];
        float s0 = 0.f, s1 = 0.f, s2 = 0.f, s3 = 0.f;
        for (int k = F.wave * 128; k < F.wave * 128 + 128; ++k) {
            const float wv = aw[(size_t)k * 6144 + col];
            s0 += silu_f(cc[k]) * wv; s1 += silu_f(cc[DM + k]) * wv; s2 += silu_f(cc[2 * DM + k]) * wv; s3 += silu_f(cc[3 * DM + k]) * wv;
        }
        LAS float* red = (LAS float*)F.lds;
        red[(F.wave * 4 + 0) * 64 + F.lane] = s0; red[(F.wave * 4 + 1) * 64 + F.lane] = s1; red[(F.wave * 4 + 2) * 64 + F.lane] = s2; red[(F.wave * 4 + 3) * 64 + F.lane] = s3;
        __syncthreads();
        if (F.tid < 256) { const int b = F.tid >> 6, cl = F.tid & 63; float s = 0.f;
            for (int w = 0; w < 8; ++w) s += red[(w * 4 + b) * 64 + cl];
            MOD[(size_t)(l * 4 + b) * 6144 + cb * 64 + cl] = s + a.in[3][l * 6144 + cb * 64 + cl]; }
        __syncthreads();
    }
    float* WSM = (float*)(ws + WS_WSM);
    for (int e = F.bid * 512 + F.tid; e < 2 * 16 * 1024; e += F.G * 512) {
        const int l = e >> 14, j = (e >> 10) & 15, k = e & 1023; const int col = j < 8 ? 2048 + j : 3592 + (j - 8);
        WSM[e] = a.in[5][((size_t)l * DM + k) * DIN + col];
    }
    LAS float* scr = (LAS float*)(F.lds + 16384 + F.wave * 12288);
    const int gw = F.bid * 8 + F.wave, NGW = F.G * 8;
    bf16_t* WB = (bf16_t*)(ws + WS_W);
    constexpr int I_IN0 = 16 * 64, I_IN1 = 16 * 48, I_IN2 = 16 * 32, I_G = 16 * 96, I_BR = 8 * 32, I_O = 16 * 32, I_UP = 16 * 128, I_DN = 64 * 32;
    constexpr int I_LAYER = I_IN0 + I_IN1 + I_IN2 + I_G + 3 * I_BR + I_O + I_UP + I_DN;
    for (int it = gw; it < 2 * I_LAYER; it += NGW) {
        const int l = it / I_LAYER; int r = it % I_LAYER;
        bf16_t* wl = WB + (size_t)l * WO_LAYER;
        const float* win = a.in[5] + (size_t)l * DM * DIN;
        if (r < I_IN0) { p0_transpose_item(win, DIN, 0, DM, wl + WO_IN, 0, 64, scr, r, F.lane); continue; } r -= I_IN0;
        if (r < I_IN1) { p0_transpose_item(win, DIN, 2056, DM, wl + WO_IN, 2048, 48, scr, r, F.lane); continue; } r -= I_IN1;
        if (r < I_IN2) { p0_transpose_item(win, DIN, 3600, DM, wl + WO_IN, 3584, 32, scr, r, F.lane); continue; } r -= I_IN2;
        if (r < I_G) { p0_transpose_item(win, DIN, 4624, DM, wl + WO_GATE, 0, 96, scr, r, F.lane); continue; } r -= I_G;
        if (r < 3 * I_BR) { const int rb = r / I_BR; p0_transpose_item(a.in[23] + (size_t)(l * 3 + rb) * 512 * DM, DM, 0, 512, wl + WO_BR + (size_t)rb * DM * 512, 0, 32, scr, r % I_BR, F.lane); continue; } r -= 3 * I_BR;
        if (r < I_O) { p0_transpose_item(a.in[24] + (size_t)l * DM * DM, DM, 0, DM, wl + WO_OUT, 0, 32, scr, r, F.lane); continue; } r -= I_O;
        if (r < I_UP) { p0_transpose_item(a.in[26] + (size_t)l * DM * DFF, DFF, 0, DM, wl + WO_UP, 0, 128, scr, r, F.lane); continue; } r -= I_UP;
        p0_transpose_item(a.in[27] + (size_t)l * DFF * DM, DM, 0, DFF, wl + WO_DOWN, 0, 32, scr, r, F.lane);
    }
}

template <bool SMALLC>
DI void phase_norm(const Ctx& F, const float* xsrc, const float* nw, const float* modl  , int sh_off, int sc_off, bf16_t* XN, const float* WSM, float* SMALL) {
    LAS float* wsm = (LAS float*)F.lds;
    if (SMALLC) { for (int e = F.tid; e < 16 * 1024 / 4; e += 512) ((LAS f32x4*)wsm)[e] = ((const f32x4*)WSM)[e]; __syncthreads(); }
    const int gw = F.bid * 8 + F.wave, NGW = F.G * 8, lane = F.lane;
    for (int blk = gw; blk < MTOK / 16; blk += NGW) {
        const int r0 = blk * 16, b = r0 >> 13;
        f32x4 Aj[4], Bj[4];
#pragma unroll
        for (int j = 0; j < 4; ++j) { const int col = 256 * j + 4 * lane; const f32x4 w = *(const f32x4*)(nw + col), sc = *(const f32x4*)(modl + b * 6144 + sc_off + col); Aj[j] = w * (sc + 1.0f); Bj[j] = *(const f32x4*)(modl + b * 6144 + sh_off + col); }
        for (int rr = 0; rr < 16; rr += 2) {
            f32x4 hv[2][4];
#pragma unroll
            for (int p = 0; p < 2; ++p) {
                const float* xr = xsrc + (size_t)(r0 + rr + p) * DM; float ss = 0.f;
#pragma unroll
                for (int j = 0; j < 4; ++j) { hv[p][j] = *(const f32x4*)(xr + 256 * j + 4 * lane); ss += hv[p][j][0] * hv[p][j][0] + hv[p][j][1] * hv[p][j][1] + hv[p][j][2] * hv[p][j][2] + hv[p][j][3] * hv[p][j][3]; }
                const float rstd = rsqrtf(wave_sum(ss) * (1.f / DM) + 1e-6f);
                bf16_t* orow = XN + (size_t)(r0 + rr + p) * DM;
#pragma unroll
                for (int j = 0; j < 4; ++j) { hv[p][j] = hv[p][j] * rstd * Aj[j] + Bj[j]; u32x2 w; w.x = pk2(hv[p][j][0], hv[p][j][1]); w.y = pk2(hv[p][j][2], hv[p][j][3]); *(u32x2*)(orow + 256 * j + 4 * lane) = w; }
            }
            if (SMALLC) {
                float o0 = 0.f, o1 = 0.f;
#pragma unroll 1
                for (int c = 0; c < 16; ++c) {
                    float a0 = 0.f, a1 = 0.f;
#pragma unroll
                    for (int j = 0; j < 4; ++j) { const f32x4 w = *(const LAS f32x4*)(wsm + c * 1024 + 256 * j + 4 * lane);
                        a0 += hv[0][j][0] * w[0] + hv[0][j][1] * w[1] + hv[0][j][2] * w[2] + hv[0][j][3] * w[3];
                        a1 += hv[1][j][0] * w[0] + hv[1][j][1] * w[1] + hv[1][j][2] * w[2] + hv[1][j][3] * w[3]; }
                    a0 = wave_sum(a0); a1 = wave_sum(a1);
                    if (lane == c) { o0 = a0; o1 = a1; }
                }
                if (lane < 16) { SMALL[(size_t)(r0 + rr) * 16 + lane] = o0; SMALL[(size_t)(r0 + rr + 1) * 16 + lane] = o1; }
            }
        }
    }
}
DI void phase_final_norm(const Ctx& F, float* x, const float* nw) {
    const int gw = F.bid * 8 + F.wave, NGW = F.G * 8, lane = F.lane;
    for (int r = gw; r < MTOK; r += NGW) {
        float* xr = x + (size_t)r * DM; f32x4 v[4]; float ss = 0.f;
#pragma unroll
        for (int j = 0; j < 4; ++j) { v[j] = *(const f32x4*)(xr + 256 * j + 4 * lane); ss += v[j][0] * v[j][0] + v[j][1] * v[j][1] + v[j][2] * v[j][2] + v[j][3] * v[j][3]; }
        const float rstd = rsqrtf(wave_sum(ss) * (1.f / DM) + 1e-6f);
#pragma unroll
        for (int j = 0; j < 4; ++j) *(f32x4*)(xr + 256 * j + 4 * lane) = v[j] * rstd * *(const f32x4*)(nw + 256 * j + 4 * lane);
    }
}

DI void gdn_prep_unit(const Ctx& F, const Args& a, int l, int unit) {
    const int h = unit & 3, c = (unit >> 2) & 127, b = unit >> 9;
    const int row0 = b * SEQ + c * 64, w = F.wave, lane = F.lane;
    bf16_t* PROJ = (bf16_t*)(a.ws + WS_PROJ);
    const bf16_t* TAIL = (const bf16_t*)(a.ws + WS_TAIL);
    LAS bf16_t* Qs = (LAS bf16_t*)(F.lds);
    LAS bf16_t* Ks = (LAS bf16_t*)(F.lds + 17408);
    LAS bf16_t* KTs = (LAS bf16_t*)(F.lds + 34816);
    LAS bf16_t* VTs = (LAS bf16_t*)(F.lds + 53248);
    LAS float* Ms = (LAS float*)(F.lds + 71680);
    LAS bf16_t* T1s = (LAS bf16_t*)(F.lds + 89088);
    LAS bf16_t* T2s = (LAS bf16_t*)(F.lds + 98304);
    LAS float* beta_s = (LAS float*)(F.lds + 107520);
    LAS float* gcum_s = (LAS float*)(F.lds + 107776);
    if (w < 6) {
        const int part = w % 3, rq = w / 3, r0 = rq * 32;
        const int col = part * 512 + h * 128 + 2 * lane;
        const float* cw = a.in[6] + (size_t)l * 4 * 1536 + col;
        float w0[4], w1[4];
#pragma unroll
        for (int k = 0; k < 4; ++k) { w0[k] = cw[k * 1536]; w1[k] = cw[k * 1536 + 1]; }
        float p0[3], p1[3];
#pragma unroll
        for (int i = 0; i < 3; ++i) {
            unsigned v = 0u;
            if (rq == 0) { if (c > 0) v = *(const unsigned*)(TAIL + ((size_t)(b * 128 + c - 1) * 3 + i) * 1536 + col); }
            else v = *(const unsigned*)(PROJ + (size_t)(row0 + 29 + i) * NPROJ + col);
            p0[i] = bflo(v); p1[i] = bfhi(v);
        }
        float va[32], vb[32];
#pragma unroll
        for (int i = 0; i < 32; ++i) {
            const unsigned v = *(const unsigned*)(PROJ + (size_t)(row0 + r0 + i) * NPROJ + col);
            const float x0 = bflo(v), x1 = bfhi(v);
            const float y0 = w0[0] * p0[0] + w0[1] * p0[1] + w0[2] * p0[2] + w0[3] * x0;
            const float y1 = w1[0] * p1[0] + w1[1] * p1[1] + w1[2] * p1[2] + w1[3] * x1;
            p0[0] = p0[1]; p0[1] = p0[2]; p0[2] = x0; p1[0] = p1[1]; p1[1] = p1[2]; p1[2] = x1;
            va[i] = silu_f(y0); vb[i] = silu_f(y1);
        }
        if (part < 2) {
            const float extra = part == 0 ? 0.08838834764831845f : 1.0f;
#pragma unroll
            for (int i = 0; i < 32; ++i) { const float ss = wave_sum(va[i] * va[i] + vb[i] * vb[i]); const float sc = rsqrtf(ss + 1e-6f) * extra; va[i] *= sc; vb[i] *= sc; }
        }
        if (part == 0) {
#pragma unroll
            for (int i = 0; i < 32; ++i) *(LAS unsigned*)(Qs + (r0 + i) * 136 + 2 * lane) = pk2(va[i], vb[i]);
        } else {
            LAS bf16_t* T = part == 1 ? KTs : VTs;
            if (part == 1) {
#pragma unroll
                for (int i = 0; i < 32; ++i) *(LAS unsigned*)(Ks + (r0 + i) * 136 + 2 * lane) = pk2(va[i], vb[i]);
            }
#pragma unroll
            for (int i = 0; i < 32; i += 2) { *(LAS unsigned*)(T + (2 * lane) * 72 + r0 + i) = pk2(va[i], va[i + 1]); *(LAS unsigned*)(T + (2 * lane + 1) * 72 + r0 + i) = pk2(vb[i], vb[i + 1]); }
        }
    } else if (w == 6) {
        const float* sm = (const float*)(a.ws + WS_SMALL) + (size_t)(row0 + lane) * 16;
        const float braw = sm[h], araw = sm[4 + h];
        const float g = -__expf(a.in[7][l * 4 + h]) * softplus_f(araw + a.in[8][l * 4 + h]);
        const float gc = wave_incl_scan(g, lane);
        beta_s[lane] = sigmoid_f(braw); gcum_s[lane] = gc;
        ((float*)(a.ws + WS_GC))[((size_t)(b * 4 + h) * 128 + c) * 64 + lane] = gc;
    }
    __syncthreads();
    {
        const int mat = w >> 2, ci = w & 3, fr = lane & 15, q = lane >> 4;
        const LAS bf16_t* Xs = mat == 0 ? Ks : Qs;
        const int cc = 16 * ci + fr; const float gcc = gcum_s[cc], bcc = beta_s[cc];
        bf16_t* QKg = (bf16_t*)(a.ws + WS_QK) + (size_t)unit * 4096;
#pragma unroll
        for (int ej = 0; ej < 4; ++ej) {
            f32x4 acc = {0.f, 0.f, 0.f, 0.f};
#pragma unroll
            for (int s = 0; s < 4; ++s) acc = MFMA16(ldfrag(Ks, 136, 16 * ej + fr, 32 * s + 8 * q), ldfrag(Xs, 136, cc, 32 * s + 8 * q), acc);
            const int e0 = 16 * ej + 4 * q; f32x4 o;
#pragma unroll
            for (int r = 0; r < 4; ++r) { const int e = e0 + r; const float dec = __expf(gcc - gcum_s[e]);
                if (mat == 0) o[r] = (e < cc) ? bcc * acc[r] * dec : 0.f; else o[r] = (e <= cc) ? acc[r] * dec : 0.f; }
            if (mat == 0) *(LAS f32x4*)(Ms + cc * 68 + e0) = o;
            else { u32x2 wv; wv.x = pk2(o[0], o[1]); wv.y = pk2(o[2], o[3]); *(u32x2*)(QKg + cc * 64 + e0) = wv; }
        }
    }
    __syncthreads();
    if (w == 0) {
        float t[64]; const float flane = (float)lane;
        LAS unsigned char* msb = (LAS unsigned char*)Ms; asm volatile("" : "+v"(msb));
#pragma unroll
        for (int i = 0; i < 64; ++i) {
            float s = fmaxf(0.f, 1.f - fabsf(flane - (float)i));
#pragma unroll
            for (int j4 = 0; j4 < i; j4 += 4) {
                const f32x4 mv = *(const LAS f32x4*)(msb + (i * 68 + j4) * 4);
                s -= mv[0] * t[j4];
                if (j4 + 1 < i) s -= mv[1] * t[j4 + 1];
                if (j4 + 2 < i) s -= mv[2] * t[j4 + 2];
                if (j4 + 3 < i) s -= mv[3] * t[j4 + 3];
            }
            t[i] = s;
        }
        const float b1 = beta_s[lane], b2 = b1 * __expf(gcum_s[lane]);
#pragma unroll
        for (int i = 0; i < 64; ++i) { T1s[i * 72 + lane] = (bf16_t)f2bf(t[i] * b1); T2s[i * 72 + lane] = (bf16_t)f2bf(t[i] * b2); }
    } else {
        const int t = F.tid - 64; const float glast = gcum_s[63];
        bf16_t* KDTg = (bf16_t*)(a.ws + WS_KDT) + (size_t)unit * 8192;
        for (int v = t; v < 1024; v += 448) {
            const int dk = v >> 3, c8 = (v & 7) * 8;
            const u32x4 kv = *(const LAS u32x4*)(KTs + dk * 72 + c8); float sc[8];
#pragma unroll
            for (int j = 0; j < 8; ++j) sc[j] = __expf(glast - gcum_s[c8 + j]);
            u32x4 o; o.x = pk2(bflo(kv.x) * sc[0], bfhi(kv.x) * sc[1]); o.y = pk2(bflo(kv.y) * sc[2], bfhi(kv.y) * sc[3]); o.z = pk2(bflo(kv.z) * sc[4], bfhi(kv.z) * sc[5]); o.w = pk2(bflo(kv.w) * sc[6], bfhi(kv.w) * sc[7]);
            *(u32x4*)(KDTg + dk * 64 + c8) = o;
        }
        for (int v = t; v < 1024; v += 448) {
            const int row = v >> 4, k8 = (v & 15) * 8;
            *(u32x4*)(PROJ + (size_t)(row0 + row) * NPROJ + PC_Q + h * 128 + k8) = *(const LAS u32x4*)(Qs + row * 136 + k8);
        }
    }
    __syncthreads();
    {
        const int fr = lane & 15, q = lane >> 4;
#pragma unroll
        for (int which = 0; which < 2; ++which) {
            const LAS bf16_t* Xt = which == 0 ? VTs : KTs; const LAS bf16_t* Tt = which == 0 ? T1s : T2s;
            const int pcol = (which == 0 ? PC_V : PC_K) + h * 128 + 16 * w + 4 * q;
#pragma unroll
            for (int ci = 0; ci < 4; ++ci) {
                f32x4 acc = {0.f, 0.f, 0.f, 0.f};
#pragma unroll
                for (int s = 0; s < 2; ++s) acc = MFMA16(ldfrag(Xt, 72, 16 * w + fr, 32 * s + 8 * q), ldfrag(Tt, 72, 16 * ci + fr, 32 * s + 8 * q), acc);
                u32x2 wv; wv.x = pk2(acc[0], acc[1]); wv.y = pk2(acc[2], acc[3]);
                *(u32x2*)(PROJ + (size_t)(row0 + 16 * ci + fr) * NPROJ + pcol) = wv;
            }
        }
    }
    __syncthreads();
}

DI void gdn_seq(const Ctx& F, const Args& a, int l, int bh) {
    const int b = bh >> 2, h = bh & 3, w = F.wave, lane = F.lane, n = lane & 31, hh = lane >> 5;
    bf16_t* PROJ = (bf16_t*)(a.ws + WS_PROJ);
    const bf16_t* QKa = (const bf16_t*)(a.ws + WS_QK);
    const bf16_t* KDTa = (const bf16_t*)(a.ws + WS_KDT);
    const float* GC = (const float*)(a.ws + WS_GC) + (size_t)bh * 128 * 64;
    LAS float* Os = (LAS float*)F.lds;
    const int dv0 = 32 * w;
    f32x16 S[4];
#pragma unroll
    for (int t = 0; t < 4; ++t)
#pragma unroll
        for (int i = 0; i < 16; ++i) S[t][i] = 0.f;
    const int nrow = F.tid >> 3, nseg = F.tid & 7;
    const float* nwp = a.in[9] + l * 128 + nseg * 16;
    for (int c = 0; c < 128; ++c) {
        const int row0 = b * SEQ + c * 64;
        LAS float* Ob = Os + (c & 1) * (64 * 132);
        if (w < 4) {
            const int unit = (b * 128 + c) * 4 + h;
            const bf16_t* wb = PROJ + (size_t)row0 * NPROJ + PC_K + h * 128;
            const bf16_t* qb = PROJ + (size_t)row0 * NPROJ + PC_Q + h * 128;
            const bf16_t* ub = PROJ + (size_t)row0 * NPROJ + PC_V + h * 128;
            const unsigned lofA = (unsigned)((n * NPROJ + 4 * hh) * 2), lofB = (unsigned)((n * 64 + 4 * hh) * 2), lofU = (unsigned)((4 * hh * NPROJ + dv0 + n) * 2);
            const bf16_t* qkb = QKa + (size_t)unit * 4096;
            const bf16_t* kdb = KDTa + (size_t)unit * 8192;
            const float* gc = GC + c * 64;
            bf16x8 Sb[4][2];
#pragma unroll
            for (int t = 0; t < 4; ++t)
#pragma unroll
                for (int s = 0; s < 2; ++s) Sb[t][s] = pack8(S[t][8 * s], S[t][8 * s + 1], S[t][8 * s + 2], S[t][8 * s + 3], S[t][8 * s + 4], S[t][8 * s + 5], S[t][8 * s + 6], S[t][8 * s + 7]);
            f32x16 WS[2];
#pragma unroll
            for (int i = 0; i < 2; ++i) {
#pragma unroll
                for (int r = 0; r < 16; ++r) WS[i][r] = 0.f;
#pragma unroll
                for (int t = 0; t < 4; ++t)
#pragma unroll
                    for (int s = 0; s < 2; ++s) {
                        WS[i] = MFMA32(ldg8x2(wb, lofA + (unsigned)((32 * i * NPROJ + 32 * t + 16 * s) * 2)), Sb[t][s], WS[i]);
                    }
            }
            bf16x8 Vb[2][2];
#pragma unroll
            for (int i = 0; i < 2; ++i) {
                float vn[16];
#pragma unroll
                for (int r = 0; r < 16; ++r) vn[r] = bf2f(*(const bf16_t*)((const char*)ub + lofU + (unsigned)((32 * i + (r & 3) + 8 * (r >> 2)) * NPROJ * 2))) - WS[i][r];
#pragma unroll
                for (int s = 0; s < 2; ++s) Vb[i][s] = pack8(vn[8 * s], vn[8 * s + 1], vn[8 * s + 2], vn[8 * s + 3], vn[8 * s + 4], vn[8 * s + 5], vn[8 * s + 6], vn[8 * s + 7]);
            }
            asm volatile("" ::: "memory");
#pragma unroll
            for (int ip = 0; ip < 2; ++ip) {
                f32x16 O;
#pragma unroll
                for (int r = 0; r < 16; ++r) O[r] = 0.f;
#pragma unroll
                for (int t = 0; t < 4; ++t)
#pragma unroll
                    for (int s = 0; s < 2; ++s) {
                        O = MFMA32(ldg8x2(qb, lofA + (unsigned)((32 * ip * NPROJ + 32 * t + 16 * s) * 2)), Sb[t][s], O);
                    }
#pragma unroll
                for (int r = 0; r < 16; ++r) O[r] *= __expf(gc[32 * ip + crow(r, hh)]);
#pragma unroll
                for (int i = 0; i <= ip; ++i)
#pragma unroll
                    for (int s = 0; s < 2; ++s) {
                        O = MFMA32(ldg8x2(qkb, lofB + (unsigned)((32 * ip * 64 + 32 * i + 16 * s) * 2)), Vb[i][s], O);
                    }
#pragma unroll
                for (int r = 0; r < 16; ++r) Ob[(32 * ip + crow(r, hh)) * 132 + dv0 + n] = O[r];
                asm volatile("" ::: "memory");
            }
            const float gt = __expf(gc[63]);
#pragma unroll
            for (int t = 0; t < 4; ++t) {
#pragma unroll
                for (int r = 0; r < 16; ++r) S[t][r] *= gt;
#pragma unroll
                for (int i = 0; i < 2; ++i)
#pragma unroll
                    for (int s = 0; s < 2; ++s) {
                        S[t] = MFMA32(ldg8x2(kdb, lofB + (unsigned)((32 * t * 64 + 32 * i + 16 * s) * 2)), Vb[i][s], S[t]);
                    }
            }
        }
        __syncthreads();
        {
            const LAS float* orow = Ob + nrow * 132 + nseg * 16;
            float ov[16]; float ss = 0.f;
#pragma unroll
            for (int j4 = 0; j4 < 4; ++j4) { const f32x4 v = *(const LAS f32x4*)(orow + 4 * j4); ov[4 * j4] = v[0]; ov[4 * j4 + 1] = v[1]; ov[4 * j4 + 2] = v[2]; ov[4 * j4 + 3] = v[3]; ss += v[0] * v[0] + v[1] * v[1] + v[2] * v[2] + v[3] * v[3]; }
            ss += __shfl_xor(ss, 1); ss += __shfl_xor(ss, 2); ss += __shfl_xor(ss, 4);
            const float rstd = rsqrtf(ss * (1.f / 128.f) + 1e-6f);
            bf16_t* zp = PROJ + (size_t)(row0 + nrow) * NPROJ + PC_GZ + h * 128 + nseg * 16;
            const u32x4 z0 = *(const u32x4*)zp, z1 = *(const u32x4*)(zp + 8);
            const unsigned zz[8] = {z0.x, z0.y, z0.z, z0.w, z1.x, z1.y, z1.z, z1.w};
            unsigned oo[8];
#pragma unroll
            for (int j = 0; j < 8; ++j) { const float za = bflo(zz[j]), zb = bfhi(zz[j]); oo[j] = pk2(ov[2 * j] * rstd * nwp[2 * j] * silu_f(za), ov[2 * j + 1] * rstd * nwp[2 * j + 1] * silu_f(zb)); }
            *(u32x4*)zp = (u32x4){oo[0], oo[1], oo[2], oo[3]}; *(u32x4*)(zp + 8) = (u32x4){oo[4], oo[5], oo[6], oo[7]};
        }
    }
    __syncthreads();
}

DI void ssd_pass_a(const Ctx& F, const Args& a, int l, int unit) {
    const int h = unit & 7, seg = (unit >> 3) & 15, b = unit >> 7, g = h >> 2;
    const int w = F.wave, lane = F.lane, tid = F.tid, fr = lane & 15, q = lane >> 4;
    const bf16_t* PROJ = (const bf16_t*)(a.ws + WS_PROJ);
    LAS bf16_t* XTs = (LAS bf16_t*)F.lds;
    LAS bf16_t* BTs = (LAS bf16_t*)(F.lds + 9216);
    LAS float* dt_s = (LAS float*)(F.lds + 27648);
    LAS float* ac_s = (LAS float*)(F.lds + 27904);
    f32x4 ST[4];
#pragma unroll
    for (int j = 0; j < 4; ++j) ST[j] = (f32x4){0.f, 0.f, 0.f, 0.f};
    int pcol = 0, cch = 0;
    if (tid < 64) { pcol = PC_SX + h * 64 + tid; cch = h * 64 + tid; } else if (tid < 192) { pcol = PC_BM + g * 128 + (tid - 64); cch = 512 + g * 128 + (tid - 64); }
    float cw[4] = {0.f, 0.f, 0.f, 0.f}, cbias = 0.f, pv[3] = {0.f, 0.f, 0.f};
    const int rseg = b * SEQ + seg * 512;
    if (tid < 192) {
#pragma unroll
        for (int k = 0; k < 4; ++k) cw[k] = a.in[10][(size_t)(l * 4 + k) * 1024 + cch];
        cbias = a.in[11][l * 1024 + cch];
        if (seg > 0) {
#pragma unroll
            for (int i = 0; i < 3; ++i) pv[i] = bf2f(PROJ[(size_t)(rseg - 3 + i) * NPROJ + pcol]);
        }
    }
    const float dtb = a.in[13][l * 8 + h], negA = -__expf(a.in[12][l * 8 + h]);
    float ltot = 0.f;
    for (int ch = 0; ch < 8; ++ch) {
        const int rowc = rseg + ch * 64;
        if (w == 3) {
            const float dtv = softplus_f(((const float*)(a.ws + WS_SMALL))[(size_t)(rowc + lane) * 16 + 8 + h] + dtb);
            const float ac = wave_incl_scan(dtv * negA, lane);
            dt_s[lane] = dtv; ac_s[lane] = ac;
        }
        __syncthreads();
        if (tid < 192) {
            const float al = ac_s[63];
            float prev = 0.f;
#pragma unroll 8
            for (int i = 0; i < 64; ++i) {
                const float x = bf2f(PROJ[(size_t)(rowc + i) * NPROJ + pcol]);
                float y = cw[0] * pv[0] + cw[1] * pv[1] + cw[2] * pv[2] + cw[3] * x + cbias;
                pv[0] = pv[1]; pv[1] = pv[2]; pv[2] = x;
                y = silu_f(y);
                if (tid < 64) y *= dt_s[i] * __expf(al - ac_s[i]);
                if (i & 1) { if (tid < 64) *(LAS unsigned*)(XTs + tid * 72 + i - 1) = pk2(prev, y); else *(LAS unsigned*)(BTs + (tid - 64) * 72 + i - 1) = pk2(prev, y); }
                prev = y;
            }
        }
        __syncthreads();
        {
            const float dc = __expf(ac_s[63]);
            ltot += ac_s[63];
#pragma unroll
            for (int pj = 0; pj < 4; ++pj) {
                ST[pj] = ST[pj] * dc;
#pragma unroll
                for (int s2 = 0; s2 < 2; ++s2) ST[pj] = MFMA16(ldfrag(BTs, 72, 16 * w + fr, 32 * s2 + 8 * q), ldfrag(XTs, 72, 16 * pj + fr, 32 * s2 + 8 * q), ST[pj]);
            }
        }
        __syncthreads();
    }
    float* SS = (float*)(a.ws + WS_SSEG) + (size_t)unit * 8192;
#pragma unroll
    for (int pj = 0; pj < 4; ++pj)
#pragma unroll
        for (int r = 0; r < 4; ++r) SS[(16 * w + 4 * q + r) * 64 + 16 * pj + fr] = ST[pj][r];
    if (tid == 0) ((float*)(a.ws + WS_LSEG))[unit] = ltot;
}

DI void ssd_pass_c(const Ctx& F, const Args& a, int l, int unit) {
    const int seg = unit & 15, g = (unit >> 4) & 1, b = unit >> 5;
    const int w = F.wave, lane = F.lane, tid = F.tid, fr = lane & 15, q = lane >> 4, hd = w >> 1, e2 = w & 1, head = g * 4 + hd;
    bf16_t* PROJ = (bf16_t*)(a.ws + WS_PROJ);
    LAS bf16_t* Cs = (LAS bf16_t*)F.lds;
    LAS bf16_t* Bs = (LAS bf16_t*)(F.lds + 17408);
    LAS bf16_t* BTs = (LAS bf16_t*)(F.lds + 34816);
    LAS bf16_t* XTs = (LAS bf16_t*)(F.lds + 53248);
    LAS float* CBs = (LAS float*)(F.lds + 90112);
    LAS float* dt_s = (LAS float*)(F.lds + 107520);
    LAS float* ac_s = (LAS float*)(F.lds + 108544);
    LAS float* rss = (LAS float*)(F.lds + 109568);
    f32x4 ST[8][2];
#pragma unroll
    for (int si = 0; si < 8; ++si)
#pragma unroll
        for (int pl = 0; pl < 2; ++pl) ST[si][pl] = (f32x4){0.f, 0.f, 0.f, 0.f};
    for (int j = 0; j < seg; ++j) {
        const int ua = (b * 16 + j) * 8 + head;
        const float dcj = __expf(((const float*)(a.ws + WS_LSEG))[ua]);
        const float* SS = (const float*)(a.ws + WS_SSEG) + (size_t)ua * 8192;
#pragma unroll
        for (int si = 0; si < 8; ++si)
#pragma unroll
            for (int pl = 0; pl < 2; ++pl)
#pragma unroll
                for (int r = 0; r < 4; ++r) ST[si][pl][r] = ST[si][pl][r] * dcj + SS[(16 * si + 4 * q + r) * 64 + 16 * (2 * e2 + pl) + fr];
    }
    int pcol, cch;
    if (tid < 256) { pcol = PC_SX + g * 256 + tid; cch = g * 256 + tid; } else if (tid < 384) { pcol = PC_BM + g * 128 + (tid - 256); cch = 512 + g * 128 + (tid - 256); } else { pcol = PC_CM + g * 128 + (tid - 384); cch = 768 + g * 128 + (tid - 384); }
    float cw[4], pv[3] = {0.f, 0.f, 0.f};
#pragma unroll
    for (int k = 0; k < 4; ++k) cw[k] = a.in[10][(size_t)(l * 4 + k) * 1024 + cch];
    const float cbias = a.in[11][l * 1024 + cch];
    const int rseg = b * SEQ + seg * 512;
    if (seg > 0) {
#pragma unroll
        for (int i = 0; i < 3; ++i) pv[i] = bf2f(PROJ[(size_t)(rseg - 3 + i) * NPROJ + pcol]);
    }
    const float dskip = a.in[14][l * 8 + head];
    float nwv[2]; nwv[0] = a.in[15][l * 512 + g * 256 + hd * 64 + 16 * (2 * e2) + fr]; nwv[1] = a.in[15][l * 512 + g * 256 + hd * 64 + 16 * (2 * e2 + 1) + fr];
    for (int ch = 0; ch < 8; ++ch) {
        const int rowc = rseg + ch * 64;
        if (w < 4) {
            const int hw = g * 4 + w;
            const float dtv = softplus_f(((const float*)(a.ws + WS_SMALL))[(size_t)(rowc + lane) * 16 + 8 + hw] + a.in[13][l * 8 + hw]);
            const float ac = wave_incl_scan(dtv * (-__expf(a.in[12][l * 8 + hw])), lane);
            dt_s[w * 64 + lane] = dtv; ac_s[w * 64 + lane] = ac;
        }
        {
#pragma unroll 8
            for (int i = 0; i < 64; ++i) {
                const float x = bf2f(PROJ[(size_t)(rowc + i) * NPROJ + pcol]);
                float y = cw[0] * pv[0] + cw[1] * pv[1] + cw[2] * pv[2] + cw[3] * x + cbias;
                pv[0] = pv[1]; pv[1] = pv[2]; pv[2] = x;
                const bf16_t yb = (bf16_t)f2bf(silu_f(y));
                if (tid < 256) XTs[tid * 72 + i] = yb;
                else if (tid < 384) { Bs[i * 136 + (tid - 256)] = yb; BTs[(tid - 256) * 72 + i] = yb; }
                else Cs[i * 136 + (tid - 384)] = yb;
            }
        }
        __syncthreads();
        {
            const int ci = w >> 1;
#pragma unroll
            for (int ee = 0; ee < 2; ++ee) {
                const int ej = 2 * (w & 1) + ee; f32x4 acc = {0.f, 0.f, 0.f, 0.f};
#pragma unroll
                for (int s = 0; s < 4; ++s) acc = MFMA16(ldfrag(Bs, 136, 16 * ej + fr, 32 * s + 8 * q), ldfrag(Cs, 136, 16 * ci + fr, 32 * s + 8 * q), acc);
                *(LAS f32x4*)(CBs + (16 * ci + fr) * 68 + 16 * ej + 4 * q) = acc;
            }
        }
        f32x4 Y[4][2];
        {
            bf16x8 STb[2][4];
#pragma unroll
            for (int pl = 0; pl < 2; ++pl)
#pragma unroll
                for (int s4 = 0; s4 < 4; ++s4) STb[pl][s4] = pack8(ST[2 * s4][pl][0], ST[2 * s4][pl][1], ST[2 * s4][pl][2], ST[2 * s4][pl][3], ST[2 * s4 + 1][pl][0], ST[2 * s4 + 1][pl][1], ST[2 * s4 + 1][pl][2], ST[2 * s4 + 1][pl][3]);
#pragma unroll
            for (int ci = 0; ci < 4; ++ci)
#pragma unroll
                for (int pl = 0; pl < 2; ++pl) {
                    f32x4 acc = {0.f, 0.f, 0.f, 0.f};
#pragma unroll
                    for (int s4 = 0; s4 < 4; ++s4) acc = MFMA16(ldfrag_perm16(Cs, 136, 16 * ci + fr, s4, q), STb[pl][s4], acc);
#pragma unroll
                    for (int r = 0; r < 4; ++r) acc[r] *= __expf(ac_s[hd * 64 + 16 * ci + 4 * q + r]);
                    Y[ci][pl] = acc;
                }
        }
        __syncthreads();
        {
            const LAS float* ach = ac_s + hd * 64; const LAS float* dth = dt_s + hd * 64;
#pragma unroll
            for (int ci = 0; ci < 4; ++ci) {
                asm volatile("" ::: "memory");
                const int cc = 16 * ci + fr; const float acc_c = ach[cc];
#pragma unroll
                for (int s2 = 0; s2 < 2; ++s2) {
                    const int e0 = 32 * s2 + 8 * q; float gv[8];
                    const f32x4 c0 = *(const LAS f32x4*)(CBs + cc * 68 + e0), c1 = *(const LAS f32x4*)(CBs + cc * 68 + e0 + 4);
#pragma unroll
                    for (int j = 0; j < 8; ++j) { const int e = e0 + j; const float cbv = j < 4 ? c0[j & 3] : c1[j & 3]; gv[j] = (e <= cc) ? cbv * __expf(acc_c - ach[e]) * dth[e] : 0.f; }
                    const bf16x8 Gf = pack8(gv[0], gv[1], gv[2], gv[3], gv[4], gv[5], gv[6], gv[7]);
#pragma unroll
                    for (int pl = 0; pl < 2; ++pl) Y[ci][pl] = MFMA16(Gf, ldfrag(XTs, 72, hd * 64 + 16 * (2 * e2 + pl) + fr, e0), Y[ci][pl]);
                }
            }
            const float al = ach[63], dc = __expf(al);
            float scv[2][8];
#pragma unroll
            for (int s2 = 0; s2 < 2; ++s2)
#pragma unroll
                for (int j = 0; j < 8; ++j) { const int cidx = 32 * s2 + 8 * q + j; scv[s2][j] = dth[cidx] * __expf(al - ach[cidx]); }
#pragma unroll
            for (int si = 0; si < 8; ++si) {
                asm volatile("" ::: "memory");
                ST[si][0] = ST[si][0] * dc; ST[si][1] = ST[si][1] * dc;
#pragma unroll
                for (int s2 = 0; s2 < 2; ++s2) {
                    const u32x4 bv = *(const LAS u32x4*)(BTs + (16 * si + fr) * 72 + 32 * s2 + 8 * q);
                    const bf16x8 Bf = pack8(bflo(bv.x) * scv[s2][0], bfhi(bv.x) * scv[s2][1], bflo(bv.y) * scv[s2][2], bfhi(bv.y) * scv[s2][3], bflo(bv.z) * scv[s2][4], bfhi(bv.z) * scv[s2][5], bflo(bv.w) * scv[s2][6], bfhi(bv.w) * scv[s2][7]);
#pragma unroll
                    for (int pl = 0; pl < 2; ++pl) ST[si][pl] = MFMA16(Bf, ldfrag(XTs, 72, hd * 64 + 16 * (2 * e2 + pl) + fr, 32 * s2 + 8 * q), ST[si][pl]);
                }
            }
        }
        {
            float part[4][4];
#pragma unroll
            for (int ci = 0; ci < 4; ++ci)
#pragma unroll
                for (int r = 0; r < 4; ++r) {
                    const int cc = 16 * ci + 4 * q + r; float ps = 0.f;
#pragma unroll
                    for (int pl = 0; pl < 2; ++pl) {
                        const int p = 16 * (2 * e2 + pl) + fr;
                        const float x = bf2f(XTs[(hd * 64 + p) * 72 + cc]);
                        const float z = bf2f(PROJ[(size_t)(rowc + cc) * NPROJ + PC_SZ + g * 256 + hd * 64 + p]);
                        const float gz = (Y[ci][pl][r] + dskip * x) * silu_f(z);
                        Y[ci][pl][r] = gz; ps += gz * gz;
                    }
                    ps += __shfl_xor(ps, 1); ps += __shfl_xor(ps, 2); ps += __shfl_xor(ps, 4); ps += __shfl_xor(ps, 8);
                    part[ci][r] = ps;
                }
            if (fr == 0) {
#pragma unroll
                for (int ci = 0; ci < 4; ++ci)
#pragma unroll
                    for (int r = 0; r < 4; ++r) rss[w * 64 + 16 * ci + 4 * q + r] = part[ci][r];
            }
            __syncthreads();
#pragma unroll
            for (int ci = 0; ci < 4; ++ci)
#pragma unroll
                for (int r = 0; r < 4; ++r) {
                    const int cc = 16 * ci + 4 * q + r; float tot = 0.f;
#pragma unroll
                    for (int ww = 0; ww < 8; ++ww) tot += rss[ww * 64 + cc];
                    const float rstd = rsqrtf(tot * (1.f / 256.f) + 1e-6f);
#pragma unroll
                    for (int pl = 0; pl < 2; ++pl) {
                        const int p = 16 * (2 * e2 + pl) + fr;
                        PROJ[(size_t)(rowc + cc) * NPROJ + PC_SZ + g * 256 + hd * 64 + p] = (bf16_t)f2bf(Y[ci][pl][r] * rstd * nwv[pl]);
                    }
                }
        }
        __syncthreads();
    }
}

template <bool FINAL>
DI void lru_pass(const Ctx& F, const Args& a, int l, int unit) {
    const int blk = unit & 7, seg = (unit >> 3) & 15, b = unit >> 7;
    const int w = F.wave, lane = F.lane, tid = F.tid, fr = lane & 15, q = lane >> 4;
    bf16_t* PROJ = (bf16_t*)(a.ws + WS_PROJ);
    LAS bf16_t* WAT = (LAS bf16_t*)F.lds;
    LAS bf16_t* WXT = (LAS bf16_t*)(F.lds + 9216);
    LAS bf16_t* XCs = (LAS bf16_t*)(F.lds + 18432);
    LAS float* XF = (LAS float*)(F.lds + 27648);
    LAS float* As = (LAS float*)(F.lds + 44288);
    LAS float* Us = (LAS float*)(F.lds + 60928);
    for (int e8 = tid; e8 < 4096; e8 += 512) {
        const int d = e8 >> 6, e = e8 & 63;
        WAT[e * 72 + d] = (bf16_t)f2bf(a.in[18][((size_t)(l * 8 + blk) * 64 + d) * 64 + e]);
        WXT[e * 72 + d] = (bf16_t)f2bf(a.in[20][((size_t)(l * 8 + blk) * 64 + d) * 64 + e]);
    }
    const int chn = blk * 64 + (tid & 63);
    float cw[4] = {0.f, 0.f, 0.f, 0.f}, cbias = 0.f, pv[3] = {0.f, 0.f, 0.f};
    const int rseg = b * SEQ + seg * 512;
    if (tid < 64) {
#pragma unroll
        for (int k = 0; k < 4; ++k) cw[k] = a.in[16][(size_t)(l * 4 + k) * 512 + chn];
        cbias = a.in[17][l * 512 + chn];
        if (seg > 0) {
#pragma unroll
            for (int i = 0; i < 3; ++i) pv[i] = bf2f(PROJ[(size_t)(rseg - 3 + i) * NPROJ + PC_LX + chn]);
        }
    }
    float hcur = 0.f, pprod = 1.f;
    if (FINAL && w == 0) {
        for (int j = 0; j < seg; ++j) hcur = hcur * ((const float*)(a.ws + WS_LRUP))[(size_t)(b * 16 + j) * 512 + chn] + ((const float*)(a.ws + WS_LRUH))[(size_t)(b * 16 + j) * 512 + chn];
    }
    float ba[2], bx[2], spl[2];
#pragma unroll
    for (int ee = 0; ee < 2; ++ee) { const int ce = blk * 64 + 16 * (2 * (w >> 2) + ee) + fr; ba[ee] = a.in[19][l * 512 + ce]; bx[ee] = a.in[21][l * 512 + ce]; spl[ee] = softplus_f(-a.in[22][l * 512 + ce]); }
    __syncthreads();
    for (int ch = 0; ch < 8; ++ch) {
        const int rowc = rseg + ch * 64;
        if (tid < 64) {
#pragma unroll 8
            for (int i = 0; i < 64; ++i) {
                const float x = bf2f(PROJ[(size_t)(rowc + i) * NPROJ + PC_LX + chn]);
                const float y = cw[0] * pv[0] + cw[1] * pv[1] + cw[2] * pv[2] + cw[3] * x + cbias;
                pv[0] = pv[1]; pv[1] = pv[2]; pv[2] = x;
                XCs[i * 72 + tid] = (bf16_t)f2bf(y); XF[i * 65 + tid] = y;
            }
        }
        __syncthreads();
        {
            const int ci = w & 3;
#pragma unroll
            for (int ee = 0; ee < 2; ++ee) {
                const int ej = 2 * (w >> 2) + ee; f32x4 aa = {0.f, 0.f, 0.f, 0.f}, ax = {0.f, 0.f, 0.f, 0.f};
#pragma unroll
                for (int s = 0; s < 2; ++s) { const bf16x8 xf = ldfrag(XCs, 72, 16 * ci + fr, 32 * s + 8 * q);
                    aa = MFMA16(xf, ldfrag(WAT, 72, 16 * ej + fr, 32 * s + 8 * q), aa); ax = MFMA16(xf, ldfrag(WXT, 72, 16 * ej + fr, 32 * s + 8 * q), ax); }
#pragma unroll
                for (int r = 0; r < 4; ++r) {
                    const int cc = 16 * ci + 4 * q + r, e = 16 * ej + fr;
                    const float rg = sigmoid_f(aa[r] + ba[ee]), ig = sigmoid_f(ax[r] + bx[ee]);
                    const float la = -8.0f * rg * spl[ee];
                    As[cc * 65 + e] = __expf(la); Us[cc * 65 + e] = sqrtf(-expm1f(2.0f * la)) * ig * XF[cc * 65 + e];
                }
            }
        }
        __syncthreads();
        if (w == 0) {
#pragma unroll 8
            for (int i = 0; i < 64; ++i) { const float av = As[i * 65 + lane], uv = Us[i * 65 + lane]; hcur = av * hcur + uv; pprod *= av; if (FINAL) As[i * 65 + lane] = hcur; }
        }
        if (FINAL) {
            __syncthreads();
            const int cc = tid >> 3, e8 = (tid & 7) * 8;
            bf16_t* gp = PROJ + (size_t)(rowc + cc) * NPROJ + PC_LG + blk * 64 + e8;
            const u32x4 gv = *(const u32x4*)gp; const unsigned gg[4] = {gv.x, gv.y, gv.z, gv.w}; unsigned oo[4];
#pragma unroll
            for (int j = 0; j < 4; ++j) oo[j] = pk2(As[cc * 65 + e8 + 2 * j] * gelu_tanh_f(bflo(gg[j])), As[cc * 65 + e8 + 2 * j + 1] * gelu_tanh_f(bfhi(gg[j])));
            *(u32x4*)gp = (u32x4){oo[0], oo[1], oo[2], oo[3]};
        }
        __syncthreads();
    }
    if (!FINAL && w == 0) {
        ((float*)(a.ws + WS_LRUP))[(size_t)(b * 16 + seg) * 512 + chn] = pprod;
        ((float*)(a.ws + WS_LRUH))[(size_t)(b * 16 + seg) * 512 + chn] = hcur;
    }
}

__global__ void __launch_bounds__(512, 2) mega_fwd(Args args) {
    extern __shared__ __attribute__((aligned(16))) unsigned char lds_raw[];
    LAS unsigned char* const ldsp = (LAS unsigned char*)lds_raw;
#define F make_ctx(ldsp)
    const int lo = args.ph_lo, hi = args.ph_hi;
    unsigned char* ws = args.ws;
    float* MOD = (float*)(ws + WS_MOD);
    bf16_t* XN = (bf16_t*)(ws + WS_XN); bf16_t* PROJ = (bf16_t*)(ws + WS_PROJ); bf16_t* MERGED = (bf16_t*)(ws + WS_MERGED);
#define IN(k) (lo <= (k) && (k) < hi)
#define SEAM(k) do { if (IN(k) && IN((k) + 1)) { __threadfence(); cg::this_grid().sync(); } } while (0)
    if (IN(0)) { phase_p0(F, args); }
    SEAM(0);
#pragma unroll 1
    for (int l = 0; l < 2; ++l) {
        const int base = 1 + 9 * l;
        const float* modl = MOD + (size_t)l * 4 * 6144;
        const bf16_t* wl = (const bf16_t*)(ws + WS_W) + (size_t)l * WO_LAYER;
        const float* xcur = l == 0 ? args.in[0] : args.out;
        if (IN(base + 0)) phase_norm<true>(F, xcur, args.in[4] + l * DM, modl, 0, 1024, XN, (const float*)(ws + WS_WSM) + (size_t)l * 16 * 1024, (float*)(ws + WS_SMALL));
        SEAM(base + 0);
        if (IN(base + 1)) {
            pg8::Gemm g{XN, wl + WO_IN, MTOK, NPROJ, DM, DM, DM}; pg8::StaticOrder S; S.init(MTOK, NPROJ, F.G, F.bid);
            pg8::EpiProj E{PROJ, (bf16_t*)(ws + WS_TAIL)};
            pg8::gemm_phase(F.lds, g, S, E);
        }
        SEAM(base + 1);
        if (IN(base + 2)) {
            for (int u = F.bid; u < 3072; u += F.G) {
                if (u < 512) ssd_pass_a(F, args, l, u);
                else if (u < 1024) lru_pass<false>(F, args, l, u - 512);
                else gdn_prep_unit(F, args, l, u - 1024);
                __syncthreads();
            }
        }
        SEAM(base + 2);
        if (IN(base + 3)) {
            if (F.bid < 16) gdn_seq(F, args, l, F.bid);
            else {
                for (int u = F.bid - 16; u < 640; u += F.G - 16) {
                    if (u < 128) ssd_pass_c(F, args, l, u); else lru_pass<true>(F, args, l, u - 128);
                    __syncthreads();
                }
            }
        }
        SEAM(base + 3);
        if (IN(base + 4)) {
            pg8::StaticOrder S; S.init(MTOK, DM, F.G, F.bid);
#pragma unroll 1
            for (int r = 0; r < 3; ++r) {
                { pg8::Gemm g{XN, wl + WO_GATE + (size_t)r * DM * DM, MTOK, DM, DM, DM, DM}; pg8::EpiGate E{PROJ, NPROJ}; pg8::gemm_phase(F.lds, g, S, E); }
                __threadfence(); __syncthreads();
                const int ycol = r == 0 ? PC_GZ : (r == 1 ? PC_SZ : PC_LG);
                pg8::Gemm g{PROJ + ycol, wl + WO_BR + (size_t)r * DM * 512, MTOK, DM, 512, NPROJ, 512};
                if (r == 0) { pg8::EpiBranch<true> E{PROJ, NPROJ, MERGED}; pg8::gemm_phase(F.lds, g, S, E); }
                else { pg8::EpiBranch<false> E{PROJ, NPROJ, MERGED}; pg8::gemm_phase(F.lds, g, S, E); }
                __threadfence(); __syncthreads();
            }
        }
        SEAM(base + 4);
        if (IN(base + 5)) {
            pg8::Gemm g{MERGED, wl + WO_OUT, MTOK, DM, DM, DM, DM}; pg8::StaticOrder S; S.init(MTOK, DM, F.G, F.bid);
            pg8::EpiResid E{xcur, args.out, modl + 2048};
            pg8::gemm_phase(F.lds, g, S, E);
        }
        SEAM(base + 5);
        if (IN(base + 6)) phase_norm<false>(F, args.out, args.in[25] + l * DM, modl, 3072, 4096, XN, nullptr, nullptr);
        SEAM(base + 6);
        if (IN(base + 7)) {
            pg8::Gemm g{XN, wl + WO_UP, MTOK, DFF, DM, DM, DM}; pg8::StaticOrder S; S.init(MTOK, DFF, F.G, F.bid);
            pg8::EpiUp E{PROJ};
            pg8::gemm_phase(F.lds, g, S, E);
        }
        SEAM(base + 7);
        if (IN(base + 8)) {
            pg8::Gemm g{PROJ, wl + WO_DOWN, MTOK, DM, DFF, DFF, DFF}; pg8::StaticOrder S; S.init(MTOK, DM, F.G, F.bid);
            pg8::EpiResid E{args.out, args.out, modl + 5120};
            pg8::gemm_phase(F.lds, g, S, E);
        }
        SEAM(base + 8);
    }
    if (IN(19)) phase_final_norm(F, args.out, args.in[28]);
#undef IN
#undef SEAM
}

extern "C" void kernel_launch(void* const* d_in, const int* in_sizes, int n_in, void* d_out, int out_size, void* d_ws, size_t ws_size, hipStream_t stream) {
    static int grid = 0;
    if (grid == 0) {
        if (n_in != 29 || out_size != MTOK * DM || ws_size < WS_END) { fprintf(stderr, "kernel_launch: unexpected problem (n_in %d out %d ws %zu)\n", n_in, out_size, ws_size); grid = -1; return; }
        int dev = 0, cus = 0, per_cu = 0;
        hipGetDevice(&dev); hipDeviceGetAttribute(&cus, hipDeviceAttributeMultiprocessorCount, dev);
        if (hipFuncSetAttribute((const void*)mega_fwd, hipFuncAttributeMaxDynamicSharedMemorySize, LDS_BYTES) != hipSuccess) { fprintf(stderr, "kernel_launch: hipFuncSetAttribute failed\n"); grid = -1; return; }
        if (hipOccupancyMaxActiveBlocksPerMultiprocessor(&per_cu, (const void*)mega_fwd, 512, LDS_BYTES) != hipSuccess || per_cu < 1) { fprintf(stderr, "kernel_launch: occupancy query says %d\n", per_cu); per_cu = 1; }
        (void)hipGetLastError();
        grid = cus * per_cu;
    }
    if (grid < 0) return;
    Args a{};
    for (int i = 0; i < 29; ++i) a.in[i] = (const float*)d_in[i];
    a.out = (float*)d_out; a.ws = (unsigned char*)d_ws;
#if MK_SINGLE
    a.ph_lo = 0; a.ph_hi = 20;
    void* kargs[] = {&a};
    hipError_t e = hipLaunchCooperativeKernel((const void*)mega_fwd, dim3(grid), dim3(512), kargs, LDS_BYTES, stream);
    if (e != hipSuccess) fprintf(stderr, "cooperative launch failed: %s (grid %d)\n", hipGetErrorString(e), grid);
#else
    for (int p = 0; p < 20; ++p) {
        a.ph_lo = p; a.ph_hi = p + 1;
        hipLaunchKernelGGL(mega_fwd, dim3(grid), dim3(512), LDS_BYTES, stream, a);
    }
#endif
}
```

```cpp
#include <hip/hip_runtime.h>
#include <hip/hip_cooperative_groups.h>
#include <cstdio>
#include <cstdint>
namespace cg = cooperative_groups;

#define LAS __attribute__((address_space(3)))
typedef unsigned short bf16_t;
typedef short bf16x8 __attribute__((ext_vector_type(8)));
typedef short s16x4 __attribute__((ext_vector_type(4)));
typedef float f32x4 __attribute__((ext_vector_type(4)));
typedef float f32x16 __attribute__((ext_vector_type(16)));
typedef unsigned u32x4 __attribute__((ext_vector_type(4)));
typedef unsigned u32x2 __attribute__((ext_vector_type(2)));
#define DI __device__ __forceinline__

#ifndef REP_A
#define REP_A 1
#endif
#ifndef REP_B
#define REP_B 1
#endif
#ifndef MK_SINGLE
#define MK_SINGLE 1
#endif

constexpr int DM = 1024, SEQ = 8192, MTOK = 32768, NPROJ = 4608, DFF = 4096, DIN = 7696;
constexpr int PC_Q = 0, PC_K = 512, PC_V = 1024, PC_GZ = 1536, PC_SX = 2048, PC_SZ = 2560, PC_BM = 3072, PC_CM = 3328, PC_LX = 3584, PC_LG = 4096;
constexpr size_t MiB = 1u << 20;
constexpr size_t WS_MOD = 0;
constexpr size_t WS_WSM = 256 * 1024;
constexpr size_t WS_GC = 1 * MiB;
constexpr size_t WS_LSEG = 1 * MiB + 512 * 1024;
constexpr size_t WS_LRUP = WS_LSEG + 4096;
constexpr size_t WS_LRUH = WS_LRUP + 128 * 1024;
constexpr size_t WS_SMALL = 2 * MiB;
constexpr size_t WS_TAIL = 4 * MiB;
constexpr size_t WS_W = 9 * MiB;
constexpr size_t WS_XN = 81 * MiB;
constexpr size_t WS_PROJ = 145 * MiB;
constexpr size_t WS_KDT = 433 * MiB;
constexpr size_t WS_QK = 465 * MiB;
constexpr size_t WS_SSEG = 481 * MiB;
constexpr size_t WS_MERGED = 433 * MiB;
constexpr size_t WS_END = 497 * MiB;
constexpr size_t WO_IN = 0, WO_GATE = 4718592, WO_BR = WO_GATE + 3145728, WO_OUT = WO_BR + 1572864, WO_UP = WO_OUT + 1048576, WO_DOWN = WO_UP + 4194304, WO_LAYER = WO_DOWN + 4194304;
constexpr int LDS_BYTES = 163840;

DI unsigned f2bf(float f) { unsigned u = __builtin_bit_cast(unsigned, f); return (u + 0x7fffu + ((u >> 16) & 1u)) >> 16; }
DI unsigned pk2(float lo, float hi) { return f2bf(lo) | (f2bf(hi) << 16); }
DI float bf2f(unsigned short v) { return __builtin_bit_cast(float, (unsigned)v << 16); }
DI float bflo(unsigned v) { return __builtin_bit_cast(float, v << 16); }
DI float bfhi(unsigned v) { return __builtin_bit_cast(float, v & 0xffff0000u); }
DI float sigmoid_f(float x) { return 1.f / (1.f + __expf(-x)); }
DI float silu_f(float x) { return x / (1.f + __expf(-x)); }
DI float softplus_f(float x) { return fmaxf(x, 0.f) + log1pf(__expf(-fabsf(x))); }
DI float gelu_tanh_f(float x) { const float u = 0.7978845608028654f * (x + 0.044715f * x * x * x); const float t = 1.f - 2.f / (1.f + __expf(2.f * u)); return 0.5f * x * (1.f + t); }
DI float wave_sum(float v) {
#pragma unroll
    for (int o = 1; o < 64; o <<= 1) v += __shfl_xor(v, o);
    return v;
}
DI float wave_incl_scan(float v, int lane) {
#pragma unroll
    for (int o = 1; o < 64; o <<= 1) { const float t = __shfl_up(v, o); if (lane >= o) v += t; }
    return v;
}
DI bf16x8 pack8(float a0, float a1, float a2, float a3, float a4, float a5, float a6, float a7) {
    u32x4 p; p.x = pk2(a0, a1); p.y = pk2(a2, a3); p.z = pk2(a4, a5); p.w = pk2(a6, a7); return __builtin_bit_cast(bf16x8, p);
}
DI bf16x8 cat4(s16x4 lo, s16x4 hi) { return __builtin_shufflevector(lo, hi, 0, 1, 2, 3, 4, 5, 6, 7); }
#define MFMA16(a, b, c) __builtin_amdgcn_mfma_f32_16x16x32_bf16((a), (b), (c), 0, 0, 0)
#define MFMA32(a, b, c) __builtin_amdgcn_mfma_f32_32x32x16_bf16((a), (b), (c), 0, 0, 0)
DI bf16x8 ldfrag(const LAS bf16_t* base, int pitch, int row, int k0) { return *(const LAS bf16x8*)(base + row * pitch + k0); }
DI bf16x8 ldfrag_perm16(const LAS bf16_t* base, int pitch, int row, int s, int q) {
    const LAS bf16_t* p = base + row * pitch + 32 * s + 4 * q; return cat4(*(const LAS s16x4*)p, *(const LAS s16x4*)(p + 16));
}
DI s16x4 ldg8(const void* base, unsigned off) { return *(const s16x4*)((const char*)base + off); }
DI bf16x8 ldg8x2(const void* base, unsigned off) { return cat4(ldg8(base, off), ldg8(base, off + 16u)); }
DI int crow(int r, int hh) { return (r & 3) + 8 * (r >> 2) + 4 * hh; }

struct Ctx { LAS unsigned char* lds; int tid, lane, wave, G, bid; };
DI Ctx make_ctx(LAS unsigned char* lds) { Ctx F; int t = threadIdx.x; asm volatile("" : "+v"(t)); F.lds = lds; F.tid = t; F.lane = t & 63; F.wave = __builtin_amdgcn_readfirstlane(t >> 6); F.G = gridDim.x; F.bid = blockIdx.x; return F; }
struct Args { const float* in[29]; float* out; unsigned char* ws; int ph_lo, ph_hi; };

namespace pg8 {
constexpr int BM = 256, BK = 64, HALF = 128, HTB = HALF * BK * 2, STAGE_BYTES = 8 * HTB, NXCD = 8, WGM = 8;
DI int lds_byte(int r, int c) { const int st = (r >> 4) * 2 + (c >> 5), rr = r & 15, cc = c & 31, ob = rr * 64 + cc * 2; return st * 1024 + (ob ^ (((ob >> 9) & 1) << 5)); }
DI void stage_rc(int b, int& R, int& C) { const int st = b / 1024, sb = b % 1024, swz = sb ^ (((sb >> 9) & 1) << 5); R = (st >> 1) * 16 + swz / 64; C = (st & 1) * 32 + (swz % 64) / 2; }
struct Unit { int pm, pn; };
struct Gemm { const bf16_t* A; const bf16_t* Bt; int M, N, K, lda, ldb; };
struct StaticOrder {
    int nM, nN, nwg, G, c;
    DI void init(int M, int N, int G_, int c_) { nM = M / BM; nN = N / BM; nwg = nM * nN; G = G_; c = c_; }
    DI bool next(int i, Unit& u) const {
        const long L = (long)i * G + c; if (L >= nwg) return false;
        int wgid = (int)L; { const int q = nwg / NXCD, r = nwg % NXCD, xcd = wgid % NXCD, off = wgid / NXCD; wgid = (xcd < r ? xcd * (q + 1) : r * (q + 1) + (xcd - r) * q) + off; }
        const int nig = WGM * nN, gid = wgid / nig, fm = gid * WGM, gsz = (nM - fm) < WGM ? (nM - fm) : WGM;
        u.pm = fm + ((wgid % nig) % gsz); u.pn = (wgid % nig) / gsz; return true;
    }
};
template <class Epi>
DI void gemm_phase(LAS unsigned char* lds, const Gemm g, const StaticOrder& S, const Epi& E) {
    int tid_ = threadIdx.x; asm volatile("" : "+v"(tid_)); const int tid = tid_, wid = __builtin_amdgcn_readfirstlane(tid >> 6), lane = tid & 63, wr = wid >> 2, wc = wid & 3, fr = lane & 15, fq = lane >> 4;
    const int K = g.K, nt = K / BK;
    unsigned voffA[2], voffB[2];
#pragma unroll
    for (int i = 0; i < 2; ++i) { int R, C; stage_rc(tid * 16 + i * 8192, R, C); voffA[i] = (unsigned)(R * g.lda + C) * 2u; voffB[i] = (unsigned)(R * g.ldb + C) * 2u; }
    const size_t kstep = (size_t)(BK * 2);
    const size_t hstepA = (size_t)HALF * g.lda * 2, hstepB = (size_t)HALF * g.ldb * 2;
    const size_t tstepA = 2 * hstepA, tstepB = 2 * hstepB;
    const unsigned ldsw = (unsigned)wid * 1024u;
    const int aoff = lds_byte(wr * 64 + fr, fq * 8), boff = lds_byte(wc * 32 + fr, fq * 8);
#define PG8_SA(b, h) (((b) * 2 + (h)) * HTB)
#define PG8_SB(b, h) ((4 + (b) * 2 + (h)) * HTB)
#define PG8_STAGE(bufoff, gbase, voff) do { _Pragma("unroll") for (int _i = 0; _i < 2; ++_i) \
        __builtin_amdgcn_global_load_lds((const unsigned*)((const char*)(gbase) + (voff)[_i]), (LAS unsigned*)(lds + (bufoff) + ldsw + _i * 8192), 16, 0, 0); } while (0)
#define PG8_LDA(dst, b, h) do { _Pragma("unroll") for (int m = 0; m < 4; ++m) _Pragma("unroll") for (int k = 0; k < 2; ++k) dst[m][k] = *(const LAS bf16x8*)(lds + PG8_SA(b, h) + aoff + m * 2048 + k * 1024); } while (0)
#define PG8_LDB(dst, b, h) do { _Pragma("unroll") for (int n = 0; n < 2; ++n) _Pragma("unroll") for (int k = 0; k < 2; ++k) dst[n][k] = *(const LAS bf16x8*)(lds + PG8_SB(b, h) + boff + n * 2048 + k * 1024); } while (0)
#define PG8_MMA(ai, bj, At, Bt) do { __builtin_amdgcn_s_setprio(1); _Pragma("unroll") for (int m = 0; m < 4; ++m) _Pragma("unroll") for (int n = 0; n < 2; ++n) _Pragma("unroll") for (int k = 0; k < 2; ++k) \
        acc[ai][bj][m][n] = __builtin_amdgcn_mfma_f32_16x16x32_bf16(Bt[n][k], At[m][k], acc[ai][bj][m][n], 0, 0, 0); __builtin_amdgcn_s_setprio(0); } while (0)
#define PG8_WAIT_V(n) asm volatile("s_waitcnt vmcnt(" #n ")" ::: "memory")
#define PG8_WAIT_L(n) asm volatile("s_waitcnt lgkmcnt(" #n ")" ::: "memory")
#define PG8_BAR __builtin_amdgcn_s_barrier()
#define PG8_SCHED __builtin_amdgcn_sched_barrier(0)
    Unit cur, nxt; int ui = 0;
    if (!S.next(0, cur)) return;
    f32x4 acc[2][2][4][2];
#pragma unroll
    for (int a = 0; a < 2; ++a)
#pragma unroll
        for (int b = 0; b < 2; ++b)
#pragma unroll
            for (int m = 0; m < 4; ++m)
#pragma unroll
                for (int n = 0; n < 2; ++n) acc[a][b][m][n] = (f32x4){0.f, 0.f, 0.f, 0.f};
    bf16x8 At[4][2], B0[2][2], B1[2][2];
    const char* cA = (const char*)g.A + (size_t)cur.pm * tstepA; const char* cB = (const char*)g.Bt + (size_t)cur.pn * tstepB;
    PG8_STAGE(PG8_SB(0, 0), cB, voffB); PG8_STAGE(PG8_SB(0, 1), cB + hstepB, voffB); PG8_STAGE(PG8_SA(0, 0), cA, voffA); PG8_STAGE(PG8_SA(0, 1), cA + hstepA, voffA);
    if (wr == 1) PG8_BAR;
    PG8_WAIT_V(2); PG8_BAR;
    PG8_STAGE(PG8_SB(1, 0), cB + kstep, voffB); PG8_STAGE(PG8_SA(1, 0), cA + kstep, voffA); PG8_STAGE(PG8_SB(1, 1), cB + hstepB + kstep, voffB);
    PG8_WAIT_V(6); PG8_BAR;
    for (;;) {
        const bool has_next = S.next(ui + 1, nxt);
        const char* nA = has_next ? (const char*)g.A + (size_t)nxt.pm * tstepA : cA; const char* nB = has_next ? (const char*)g.Bt + (size_t)nxt.pn * tstepB : cB;
        for (int t = 0; t < nt; t += 2) {
            const bool last = (t == nt - 2);
            const char* a1 = cA + (size_t)(t + 1) * kstep;
            const char* a2 = last ? nA : cA + (size_t)(t + 2) * kstep; const char* b2 = last ? nB : cB + (size_t)(t + 2) * kstep;
            const char* a3 = a2 + kstep; const char* b3 = b2 + kstep;
            PG8_LDB(B0, 0, 0); PG8_LDB(B1, 0, 1); PG8_SCHED; PG8_LDA(At, 0, 0); PG8_STAGE(PG8_SA(1, 1), a1 + hstepA, voffA);
            PG8_WAIT_V(8); PG8_WAIT_L(0); PG8_BAR; PG8_MMA(0, 0, At, B0); PG8_MMA(0, 1, At, B1); PG8_BAR; PG8_SCHED;
            PG8_LDA(At, 0, 1); PG8_STAGE(PG8_SB(0, 0), b2, voffB); PG8_STAGE(PG8_SB(0, 1), b2 + hstepB, voffB); PG8_STAGE(PG8_SA(0, 0), a2, voffA);
            PG8_WAIT_V(8); PG8_WAIT_L(0); PG8_BAR; PG8_MMA(1, 0, At, B0); PG8_MMA(1, 1, At, B1); PG8_BAR; PG8_SCHED;
            PG8_LDB(B0, 1, 0); PG8_LDB(B1, 1, 1); PG8_SCHED; PG8_LDA(At, 1, 0); PG8_STAGE(PG8_SA(0, 1), a2 + hstepA, voffA);
            PG8_WAIT_V(8); PG8_WAIT_L(0); PG8_BAR; PG8_MMA(0, 0, At, B0); PG8_MMA(0, 1, At, B1); PG8_BAR; PG8_SCHED;
            PG8_LDA(At, 1, 1); PG8_STAGE(PG8_SB(1, 0), b3, voffB); PG8_STAGE(PG8_SB(1, 1), b3 + hstepB, voffB); PG8_STAGE(PG8_SA(1, 0), a3, voffA);
            PG8_WAIT_V(8); PG8_WAIT_L(0); PG8_BAR; PG8_MMA(1, 0, At, B0); PG8_MMA(1, 1, At, B1); PG8_BAR; PG8_SCHED;
        }
        if (wr == 0) PG8_BAR;
        E(acc, cur, wr, wc, fr, fq);
        if (!has_next) break;
#pragma unroll
        for (int a = 0; a < 2; ++a)
#pragma unroll
            for (int b = 0; b < 2; ++b)
#pragma unroll
                for (int m = 0; m < 4; ++m)
#pragma unroll
                    for (int n = 0; n < 2; ++n) acc[a][b][m][n] = (f32x4){0.f, 0.f, 0.f, 0.f};
        cur = nxt; cA = nA; cB = nB; ++ui;
        if (wr == 1) PG8_BAR;
    }
    PG8_WAIT_V(0);
    PG8_BAR;
#undef PG8_SA
#undef PG8_SB
#undef PG8_STAGE
#undef PG8_LDA
#undef PG8_LDB
#undef PG8_MMA
#undef PG8_WAIT_V
#undef PG8_WAIT_L
#undef PG8_BAR
#undef PG8_SCHED
}
#define PG8_FOREACH(body) \
    _Pragma("unroll") for (int ai = 0; ai < 2; ++ai) _Pragma("unroll") for (int m = 0; m < 4; ++m) { const int row = u.pm * BM + ai * HALF + wr * 64 + m * 16 + fr; \
    _Pragma("unroll") for (int bj = 0; bj < 2; ++bj) _Pragma("unroll") for (int n = 0; n < 2; ++n) { const int col = u.pn * BM + bj * HALF + wc * 32 + n * 16 + 4 * fq; const f32x4 v = acc[ai][bj][m][n]; body } }

struct EpiProj {
    bf16_t* P; bf16_t* tail;
    DI void operator()(const f32x4 (&acc)[2][2][4][2], const Unit& u, int wr, int wc, int fr, int fq) const {
        PG8_FOREACH({ u32x2 w; w.x = pk2(v[0], v[1]); w.y = pk2(v[2], v[3]); *(u32x2*)(P + (size_t)row * NPROJ + col) = w;
            if (col < 1536 && (row & 63) >= 61) *(u32x2*)(tail + ((size_t)(row >> 6) * 3 + ((row & 63) - 61)) * 1536 + col) = w; })
    }
};
struct EpiGate {
    bf16_t* P; int ldc;
    DI void operator()(const f32x4 (&acc)[2][2][4][2], const Unit& u, int wr, int wc, int fr, int fq) const {
        PG8_FOREACH({ u32x2 w; w.x = pk2(sigmoid_f(v[0]), sigmoid_f(v[1])); w.y = pk2(sigmoid_f(v[2]), sigmoid_f(v[3])); *(u32x2*)(P + (size_t)row * ldc + col) = w; })
    }
};
template <bool FIRST> struct EpiBranch {
    const bf16_t* GT; int ldg; bf16_t* Mg;
    DI void operator()(const f32x4 (&acc)[2][2][4][2], const Unit& u, int wr, int wc, int fr, int fq) const {
        PG8_FOREACH({ const u32x2 gg = *(const u32x2*)(GT + (size_t)row * ldg + col); f32x4 o;
            o[0] = bflo(gg.x) * v[0]; o[1] = bfhi(gg.x) * v[1]; o[2] = bflo(gg.y) * v[2]; o[3] = bfhi(gg.y) * v[3];
            bf16_t* mp = Mg + (size_t)row * DM + col;
            if (!FIRST) { const u32x2 mm = *(const u32x2*)mp; o[0] += bflo(mm.x); o[1] += bfhi(mm.x); o[2] += bflo(mm.y); o[3] += bfhi(mm.y); }
            u32x2 w; w.x = pk2(o[0], o[1]); w.y = pk2(o[2], o[3]); *(u32x2*)mp = w; })
    }
};
struct EpiResid {
    const float* xin; float* xout; const float* gate;
    DI void operator()(const f32x4 (&acc)[2][2][4][2], const Unit& u, int wr, int wc, int fr, int fq) const {
        PG8_FOREACH({ const int b = row >> 13; const f32x4 gv = *(const f32x4*)(gate + b * 6144 + col); const f32x4 xv = *(const f32x4*)(xin + (size_t)row * DM + col);
            *(f32x4*)(xout + (size_t)row * DM + col) = xv + gv * v; })
    }
};
struct EpiUp {
    bf16_t* H;
    DI void operator()(const f32x4 (&acc)[2][2][4][2], const Unit& u, int wr, int wc, int fr, int fq) const {
        PG8_FOREACH({ f32x4 r; for (int e = 0; e < 4; ++e) { const float t = fmaxf(v[e], 0.f); r[e] = t * t; } u32x2 w; w.x = pk2(r[0], r[1]); w.y = pk2(r[2], r[3]); *(u32x2*)(H + (size_t)row * DFF + col) = w; })
    }
};
}

DI void p0_transpose_item(const float* W, int ldw, int col0, int K, bf16_t* WT, int row0, int nblk, LAS float* scr, int item, int lane) {
    const int kb = item / nblk, nb = item % nblk, k0 = 64 * kb, n0 = 32 * nb;
#pragma unroll 8
    for (int i = 0; i < 32; ++i) { const int kk = 2 * i + (lane >> 5); scr[kk * 33 + (lane & 31)] = W[(size_t)(k0 + kk) * ldw + col0 + n0 + (lane & 31)]; }
    asm volatile("s_waitcnt lgkmcnt(0)" ::: "memory");
    const int c = lane & 7;
#pragma unroll
    for (int j = 0; j < 4; ++j) { const int n = (lane >> 3) + 8 * j; const LAS float* s = scr + (8 * c) * 33 + n;
        u32x4 o; o.x = pk2(s[0 * 33], s[1 * 33]); o.y = pk2(s[2 * 33], s[3 * 33]); o.z = pk2(s[4 * 33], s[5 * 33]); o.w = pk2(s[6 * 33], s[7 * 33]);
        *(u32x4*)(WT + (size_t)(row0 + n0 + n) * K + k0 + 8 * c) = o; }
    asm volatile("s_waitcnt lgkmcnt(0)" ::: "memory");
}

DI void phase_p0(const Ctx& F, const Args& a) {
    unsigned char* ws = a.ws;
    float* MOD = (float*)(ws + WS_MOD);
    for (int it = F.bid; it < 192; it += F.G) {
        const int l = it / 96, cb = it % 96, col = cb * 64 + F.lane;
        const float* aw = a.in[2] + (size_t)l * DM * 6144; const float* cc = a.in[1];
        float s0 = 0.f, s1 = 0.f, s2 = 0.f, s3 = 0.f;
        for (int k = F.wave * 128; k < F.wave * 128 + 128; ++k) {
            const float wv = aw[(size_t)k * 6144 + col];
            s0 += silu_f(cc[k]) * wv; s1 += silu_f(cc[DM + k]) * wv; s2 += silu_f(cc[2 * DM + k]) * wv; s3 += silu_f(cc[3 * DM + k]) * wv;
        }
        LAS float* red = (LAS float*)F.lds;
        red[(F.wave * 4 + 0) * 64 + F.lane] = s0; red[(F.wave * 4 + 1) * 64 + F.lane] = s1; red[(F.wave * 4 + 2) * 64 + F.lane] = s2; red[(F.wave * 4 + 3) * 64 + F.lane] = s3;
        __syncthreads();
        if (F.tid < 256) { const int b = F.tid >> 6, cl = F.tid & 63; float s = 0.f;
            for (int w = 0; w < 8; ++w) s += red[(w * 4 + b) * 64 + cl];
            MOD[(size_t)(l * 4 + b) * 6144 + cb * 64 + cl] = s + a.in[3][l * 6144 + cb * 64 + cl]; }
        __syncthreads();
    }
    float* WSM = (float*)(ws + WS_WSM);
    for (int e = F.bid * 512 + F.tid; e < 2 * 16 * 1024; e += F.G * 512) {
        const int l = e >> 14, j = (e >> 10) & 15, k = e & 1023; const int col = j < 8 ? 2048 + j : 3592 + (j - 8);
        WSM[e] = a.in[5][((size_t)l * DM + k) * DIN + col];
    }
    LAS float* scr = (LAS float*)(F.lds + 16384 + F.wave * 12288);
    const int gw = F.bid * 8 + F.wave, NGW = F.G * 8;
    bf16_t* WB = (bf16_t*)(ws + WS_W);
    constexpr int I_IN0 = 16 * 64, I_IN1 = 16 * 48, I_IN2 = 16 * 32, I_G = 16 * 96, I_BR = 8 * 32, I_O = 16 * 32, I_UP = 16 * 128, I_DN = 64 * 32;
    constexpr int I_LAYER = I_IN0 + I_IN1 + I_IN2 + I_G + 3 * I_BR + I_O + I_UP + I_DN;
    for (int it = gw; it < 2 * I_LAYER; it += NGW) {
        const int l = it / I_LAYER; int r = it % I_LAYER;
        bf16_t* wl = WB + (size_t)l * WO_LAYER;
        const float* win = a.in[5] + (size_t)l * DM * DIN;
        if (r < I_IN0) { p0_transpose_item(win, DIN, 0, DM, wl + WO_IN, 0, 64, scr, r, F.lane); continue; } r -= I_IN0;
        if (r < I_IN1) { p0_transpose_item(win, DIN, 2056, DM, wl + WO_IN, 2048, 48, scr, r, F.lane); continue; } r -= I_IN1;
        if (r < I_IN2) { p0_transpose_item(win, DIN, 3600, DM, wl + WO_IN, 3584, 32, scr, r, F.lane); continue; } r -= I_IN2;
        if (r < I_G) { p0_transpose_item(win, DIN, 4624, DM, wl + WO_GATE, 0, 96, scr, r, F.lane); continue; } r -= I_G;
        if (r < 3 * I_BR) { const int rb = r / I_BR; p0_transpose_item(a.in[23] + (size_t)(l * 3 + rb) * 512 * DM, DM, 0, 512, wl + WO_BR + (size_t)rb * DM * 512, 0, 32, scr, r % I_BR, F.lane); continue; } r -= 3 * I_BR;
        if (r < I_O) { p0_transpose_item(a.in[24] + (size_t)l * DM * DM, DM, 0, DM, wl + WO_OUT, 0, 32, scr, r, F.lane); continue; } r -= I_O;
        if (r < I_UP) { p0_transpose_item(a.in[26] + (size_t)l * DM * DFF, DFF, 0, DM, wl + WO_UP, 0, 128, scr, r, F.lane); continue; } r -= I_UP;
        p0_transpose_item(a.in[27] + (size_t)l * DFF * DM, DM, 0, DFF, wl + WO_DOWN, 0, 32, scr, r, F.lane);
    }
}

template <bool SMALLC>
DI void phase_norm(const Ctx& F, const float* xsrc, const float* nw, const float* modl  , int sh_off, int sc_off, bf16_t* XN, const float* WSM, float* SMALL) {
    LAS float* wsm = (LAS float*)F.lds;
    if (SMALLC) { for (int e = F.tid; e < 16 * 1024 / 4; e += 512) ((LAS f32x4*)wsm)[e] = ((const f32x4*)WSM)[e]; __syncthreads(); }
    const int gw = F.bid * 8 + F.wave, NGW = F.G * 8, lane = F.lane;
    for (int blk = gw; blk < MTOK / 16; blk += NGW) {
        const int r0 = blk * 16, b = r0 >> 13;
        f32x4 Aj[4], Bj[4];
#pragma unroll
        for (int j = 0; j < 4; ++j) { const int col = 256 * j + 4 * lane; const f32x4 w = *(const f32x4*)(nw + col), sc = *(const f32x4*)(modl + b * 6144 + sc_off + col); Aj[j] = w * (sc + 1.0f); Bj[j] = *(const f32x4*)(modl + b * 6144 + sh_off + col); }
        for (int rr = 0; rr < 16; rr += 2) {
            f32x4 hv[2][4];
#pragma unroll
            for (int p = 0; p < 2; ++p) {
                const float* xr = xsrc + (size_t)(r0 + rr + p) * DM; float ss = 0.f;
#pragma unroll
                for (int j = 0; j < 4; ++j) { hv[p][j] = *(const f32x4*)(xr + 256 * j + 4 * lane); ss += hv[p][j][0] * hv[p][j][0] + hv[p][j][1] * hv[p][j][1] + hv[p][j][2] * hv[p][j][2] + hv[p][j][3] * hv[p][j][3]; }
                const float rstd = rsqrtf(wave_sum(ss) * (1.f / DM) + 1e-6f);
                bf16_t* orow = XN + (size_t)(r0 + rr + p) * DM;
#pragma unroll
                for (int j = 0; j < 4; ++j) { hv[p][j] = hv[p][j] * rstd * Aj[j] + Bj[j]; u32x2 w; w.x = pk2(hv[p][j][0], hv[p][j][1]); w.y = pk2(hv[p][j][2], hv[p][j][3]); *(u32x2*)(orow + 256 * j + 4 * lane) = w; }
            }
            if (SMALLC) {
                float o0 = 0.f, o1 = 0.f;
#pragma unroll 1
                for (int c = 0; c < 16; ++c) {
                    float a0 = 0.f, a1 = 0.f;
#pragma unroll
                    for (int j = 0; j < 4; ++j) { const f32x4 w = *(const LAS f32x4*)(wsm + c * 1024 + 256 * j + 4 * lane);
                        a0 += hv[0][j][0] * w[0] + hv[0][j][1] * w[1] + hv[0][j][2] * w[2] + hv[0][j][3] * w[3];
                        a1 += hv[1][j][0] * w[0] + hv[1][j][1] * w[1] + hv[1][j][2] * w[2] + hv[1][j][3] * w[3]; }
                    a0 = wave_sum(a0); a1 = wave_sum(a1);
                    if (lane == c) { o0 = a0; o1 = a1; }
                }
                if (lane < 16) { SMALL[(size_t)(r0 + rr) * 16 + lane] = o0; SMALL[(size_t)(r0 + rr + 1) * 16 + lane] = o1; }
            }
        }
    }
}
DI void phase_final_norm(const Ctx& F, float* x, const float* nw) {
    const int gw = F.bid * 8 + F.wave, NGW = F.G * 8, lane = F.lane;
    for (int r = gw; r < MTOK; r += NGW) {
        float* xr = x + (size_t)r * DM; f32x4 v[4]; float ss = 0.f;
#pragma unroll
        for (int j = 0; j < 4; ++j) { v[j] = *(const f32x4*)(xr + 256 * j + 4 * lane); ss += v[j][0] * v[j][0] + v[j][1] * v[j][1] + v[j][2] * v[j][2] + v[j][3] * v[j][3]; }
        const float rstd = rsqrtf(wave_sum(ss) * (1.f / DM) + 1e-6f);
#pragma unroll
        for (int j = 0; j < 4; ++j) *(f32x4*)(xr + 256 * j + 4 * lane) = v[j] * rstd * *(const f32x4*)(nw + 256 * j + 4 * lane);
    }
}

DI void gdn_prep_unit(const Ctx& F, const Args& a, int l, int unit) {
    const int h = unit & 3, c = (unit >> 2) & 127, b = unit >> 9;
    const int row0 = b * SEQ + c * 64, w = F.wave, lane = F.lane;
    bf16_t* PROJ = (bf16_t*)(a.ws + WS_PROJ);
    const bf16_t* TAIL = (const bf16_t*)(a.ws + WS_TAIL);
    LAS bf16_t* Qs = (LAS bf16_t*)(F.lds);
    LAS bf16_t* Ks = (LAS bf16_t*)(F.lds + 17408);
    LAS bf16_t* KTs = (LAS bf16_t*)(F.lds + 34816);
    LAS bf16_t* VTs = (LAS bf16_t*)(F.lds + 53248);
    LAS float* Ms = (LAS float*)(F.lds + 71680);
    LAS bf16_t* T1s = (LAS bf16_t*)(F.lds + 89088);
    LAS bf16_t* T2s = (LAS bf16_t*)(F.lds + 98304);
    LAS float* beta_s = (LAS float*)(F.lds + 107520);
    LAS float* gcum_s = (LAS float*)(F.lds + 107776);
    if (w < 6) {
        const int part = w % 3, rq = w / 3, r0 = rq * 32;
        const int col = part * 512 + h * 128 + 2 * lane;
        const float* cw = a.in[6] + (size_t)l * 4 * 1536 + col;
        float w0[4], w1[4];
#pragma unroll
        for (int k = 0; k < 4; ++k) { w0[k] = cw[k * 1536]; w1[k] = cw[k * 1536 + 1]; }
        float p0[3], p1[3];
#pragma unroll
        for (int i = 0; i < 3; ++i) {
            unsigned v = 0u;
            if (rq == 0) { if (c > 0) v = *(const unsigned*)(TAIL + ((size_t)(b * 128 + c - 1) * 3 + i) * 1536 + col); }
            else v = *(const unsigned*)(PROJ + (size_t)(row0 + 29 + i) * NPROJ + col);
            p0[i] = bflo(v); p1[i] = bfhi(v);
        }
        float va[32], vb[32];
#pragma unroll
        for (int i = 0; i < 32; ++i) {
            const unsigned v = *(const unsigned*)(PROJ + (size_t)(row0 + r0 + i) * NPROJ + col);
            const float x0 = bflo(v), x1 = bfhi(v);
            const float y0 = w0[0] * p0[0] + w0[1] * p0[1] + w0[2] * p0[2] + w0[3] * x0;
            const float y1 = w1[0] * p1[0] + w1[1] * p1[1] + w1[2] * p1[2] + w1[3] * x1;
            p0[0] = p0[1]; p0[1] = p0[2]; p0[2] = x0; p1[0] = p1[1]; p1[1] = p1[2]; p1[2] = x1;
            va[i] = silu_f(y0); vb[i] = silu_f(y1);
        }
        if (part < 2) {
            const float extra = part == 0 ? 0.08838834764831845f : 1.0f;
#pragma unroll
            for (int i = 0; i < 32; ++i) { const float ss = wave_sum(va[i] * va[i] + vb[i] * vb[i]); const float sc = rsqrtf(ss + 1e-6f) * extra; va[i] *= sc; vb[i] *= sc; }
        }
        if (part == 0) {
#pragma unroll
            for (int i = 0; i < 32; ++i) *(LAS unsigned*)(Qs + (r0 + i) * 136 + 2 * lane) = pk2(va[i], vb[i]);
        } else {
            LAS bf16_t* T = part == 1 ? KTs : VTs;
            if (part == 1) {
#pragma unroll
                for (int i = 0; i < 32; ++i) *(LAS unsigned*)(Ks + (r0 + i) * 136 + 2 * lane) = pk2(va[i], vb[i]);
            }
#pragma unroll
            for (int i = 0; i < 32; i += 2) { *(LAS unsigned*)(T + (2 * lane) * 72 + r0 + i) = pk2(va[i], va[i + 1]); *(LAS unsigned*)(T + (2 * lane + 1) * 72 + r0 + i) = pk2(vb[i], vb[i + 1]); }
        }
    } else if (w == 6) {
        const float* sm = (const float*)(a.ws + WS_SMALL) + (size_t)(row0 + lane) * 16;
        const float braw = sm[h], araw = sm[4 + h];
        const float g = -__expf(a.in[7][l * 4 + h]) * softplus_f(araw + a.in[8][l * 4 + h]);
        const float gc = wave_incl_scan(g, lane);
        beta_s[lane] = sigmoid_f(braw); gcum_s[lane] = gc;
        ((float*)(a.ws + WS_GC))[((size_t)(b * 4 + h) * 128 + c) * 64 + lane] = gc;
    }
    __syncthreads();
    {
        const int mat = w >> 2, ci = w & 3, fr = lane & 15, q = lane >> 4;
        const LAS bf16_t* Xs = mat == 0 ? Ks : Qs;
        const int cc = 16 * ci + fr; const float gcc = gcum_s[cc], bcc = beta_s[cc];
        bf16_t* QKg = (bf16_t*)(a.ws + WS_QK) + (size_t)unit * 4096;
#pragma unroll
        for (int ej = 0; ej < 4; ++ej) {
            f32x4 acc = {0.f, 0.f, 0.f, 0.f};
#pragma unroll
            for (int s = 0; s < 4; ++s) acc = MFMA16(ldfrag(Ks, 136, 16 * ej + fr, 32 * s + 8 * q), ldfrag(Xs, 136, cc, 32 * s + 8 * q), acc);
            const int e0 = 16 * ej + 4 * q; f32x4 o;
#pragma unroll
            for (int r = 0; r < 4; ++r) { const int e = e0 + r; const float dec = __expf(gcc - gcum_s[e]);
                if (mat == 0) o[r] = (e < cc) ? bcc * acc[r] * dec : 0.f; else o[r] = (e <= cc) ? acc[r] * dec : 0.f; }
            if (mat == 0) *(LAS f32x4*)(Ms + cc * 68 + e0) = o;
            else { u32x2 wv; wv.x = pk2(o[0], o[1]); wv.y = pk2(o[2], o[3]); *(u32x2*)(QKg + cc * 64 + 16 * ej + 4 * (((q & 1) << 1) | (q >> 1))) = wv; }
        }
    }
    __syncthreads();
    if (w == 0) {
        float t[64]; const float flane = (float)lane;
        LAS unsigned char* msb = (LAS unsigned char*)Ms; asm volatile("" : "+v"(msb));
#pragma unroll
        for (int i = 0; i < 64; ++i) {
            float s = fmaxf(0.f, 1.f - fabsf(flane - (float)i));
#pragma unroll
            for (int j4 = 0; j4 < i; j4 += 4) {
                const f32x4 mv = *(const LAS f32x4*)(msb + (i * 68 + j4) * 4);
                s -= mv[0] * t[j4];
                if (j4 + 1 < i) s -= mv[1] * t[j4 + 1];
                if (j4 + 2 < i) s -= mv[2] * t[j4 + 2];
                if (j4 + 3 < i) s -= mv[3] * t[j4 + 3];
            }
            t[i] = s;
        }
        const float b1 = beta_s[lane], b2 = b1 * __expf(gcum_s[lane]);
#pragma unroll
        for (int i = 0; i < 64; ++i) { T1s[i * 72 + lane] = (bf16_t)f2bf(t[i] * b1); T2s[i * 72 + lane] = (bf16_t)f2bf(t[i] * b2); }
    } else {
        const int t = F.tid - 64; const float glast = gcum_s[63];
        bf16_t* KDTg = (bf16_t*)(a.ws + WS_KDT) + (size_t)unit * 8192;
        for (int v = t; v < 1024; v += 448) {
            const int dk = v >> 3, c8 = (v & 7) * 8;
            const u32x4 kv = *(const LAS u32x4*)(KTs + dk * 72 + c8); float sc[8];
#pragma unroll
            for (int j = 0; j < 8; ++j) sc[j] = __expf(glast - gcum_s[c8 + j]);
            u32x4 o; o.x = pk2(bflo(kv.x) * sc[0], bfhi(kv.x) * sc[1]); o.y = pk2(bflo(kv.y) * sc[2], bfhi(kv.y) * sc[3]); o.z = pk2(bflo(kv.z) * sc[4], bfhi(kv.z) * sc[5]); o.w = pk2(bflo(kv.w) * sc[6], bfhi(kv.w) * sc[7]);
            { const int b16 = c8 & ~15, hf = (c8 >> 3) & 1; *(u32x2*)(KDTg + dk * 64 + b16 + 4 * hf) = (u32x2){o.x, o.y}; *(u32x2*)(KDTg + dk * 64 + b16 + 8 + 4 * hf) = (u32x2){o.z, o.w}; }
        }
        for (int v = t; v < 1024; v += 448) {
            const int row = v >> 4, k8 = (v & 15) * 8;
            { const u32x4 qv = *(const LAS u32x4*)(Qs + row * 136 + k8); const int b16 = k8 & ~15, hf = (k8 >> 3) & 1; bf16_t* qp = PROJ + (size_t)(row0 + row) * NPROJ + PC_Q + h * 128 + b16;
              *(u32x2*)(qp + 4 * hf) = (u32x2){qv.x, qv.y}; *(u32x2*)(qp + 8 + 4 * hf) = (u32x2){qv.z, qv.w}; }
        }
    }
    __syncthreads();
    {
        const int fr = lane & 15, q = lane >> 4;
#pragma unroll
        for (int ci = 0; ci < 4; ++ci) {
            f32x4 acc = {0.f, 0.f, 0.f, 0.f};
#pragma unroll
            for (int s = 0; s < 2; ++s) acc = MFMA16(ldfrag(KTs, 72, 16 * w + fr, 32 * s + 8 * q), ldfrag(T2s, 72, 16 * ci + fr, 32 * s + 8 * q), acc);
            u32x2 wv; wv.x = pk2(acc[0], acc[1]); wv.y = pk2(acc[2], acc[3]);
            *(u32x2*)(PROJ + (size_t)(row0 + 16 * ci + fr) * NPROJ + PC_K + h * 128 + 16 * w + 4 * (((q & 1) << 1) | (q >> 1))) = wv;
            f32x4 au = {0.f, 0.f, 0.f, 0.f};
#pragma unroll
            for (int s = 0; s < 2; ++s) au = MFMA16(ldfrag(T1s, 72, 16 * ci + fr, 32 * s + 8 * q), ldfrag(VTs, 72, 16 * w + fr, 32 * s + 8 * q), au);
            const int L = (w >> 1) * 64 + (q & 1) * 32 + 16 * (w & 1) + fr, pos = (ci >> 1) * 16 + 4 * (2 * (ci & 1) + (q >> 1));
            u32x2 uv; uv.x = pk2(au[0], au[1]); uv.y = pk2(au[2], au[3]);
            *(u32x2*)(PROJ + (size_t)(row0 + (L >> 2)) * NPROJ + PC_V + h * 128 + (L & 3) * 32 + pos) = uv;
        }
    }
    __syncthreads();
}

DI void gdn_seq(const Ctx& F, const Args& a, int l, int bh) {
    const int b = bh >> 2, h = bh & 3, w = F.wave, lane = F.lane, n = lane & 31, hh = lane >> 5;
    bf16_t* PROJ = (bf16_t*)(a.ws + WS_PROJ);
    const bf16_t* QKa = (const bf16_t*)(a.ws + WS_QK);
    const bf16_t* KDTa = (const bf16_t*)(a.ws + WS_KDT);
    const float* GC = (const float*)(a.ws + WS_GC) + (size_t)bh * 128 * 64;
    constexpr int BUFB = 62464, OFF_Q = 17408, OFF_QK = 34816, OFF_KD = 44032, OFF_GC = 2 * BUFB, OFF_OS = OFF_GC + 512;
    LAS float* gcs = (LAS float*)(F.lds + OFF_GC);
    LAS float* Os = (LAS float*)(F.lds + OFF_OS);
    const int rowb = b * SEQ;
    if (w < 4) {
        const int dv0 = 32 * w;
        f32x16 S[4];
#pragma unroll
        for (int t = 0; t < 4; ++t)
#pragma unroll
            for (int i = 0; i < 16; ++i) S[t][i] = 0.f;
        const int L = w * 64 + lane;
        const bf16_t* urec = PROJ + (size_t)(rowb + (L >> 2)) * NPROJ + PC_V + h * 128 + (L & 3) * 32;
        u32x4 ucur[4], unext[4];
#pragma unroll
        for (int j = 0; j < 4; ++j) { ucur[j] = *(const u32x4*)(urec + 8 * j); unext[j] = ucur[j]; }
        __syncthreads();
        for (int c = 0; c < 128; ++c) {
            const LAS bf16_t* Wl = (const LAS bf16_t*)(F.lds + (c & 1) * BUFB);
            const LAS bf16_t* Ql = (const LAS bf16_t*)(F.lds + (c & 1) * BUFB + OFF_Q);
            const LAS bf16_t* QKl = (const LAS bf16_t*)(F.lds + (c & 1) * BUFB + OFF_QK);
            const LAS bf16_t* KDl = (const LAS bf16_t*)(F.lds + (c & 1) * BUFB + OFF_KD);
            const LAS float* gc = gcs + (c & 1) * 64;
            if (c + 1 < 128) {
                const bf16_t* un = urec + (size_t)(c + 1) * 64 * NPROJ;
#pragma unroll
                for (int j = 0; j < 4; ++j) unext[j] = *(const u32x4*)(un + 8 * j);
            }
            bf16x8 Sb[4][2];
#pragma unroll
            for (int t = 0; t < 4; ++t)
#pragma unroll
                for (int s = 0; s < 2; ++s) Sb[t][s] = pack8(S[t][8 * s], S[t][8 * s + 1], S[t][8 * s + 2], S[t][8 * s + 3], S[t][8 * s + 4], S[t][8 * s + 5], S[t][8 * s + 6], S[t][8 * s + 7]);
            bf16x8 Vb[2][2];
#pragma unroll
            for (int i = 0; i < 2; ++i) {
                f32x16 WS;
#pragma unroll
                for (int r = 0; r < 16; ++r) WS[r] = 0.f;
#pragma unroll
                for (int t = 0; t < 4; ++t)
#pragma unroll
                    for (int s = 0; s < 2; ++s) WS = MFMA32(ldfrag(Wl, 136, 32 * i + n, 32 * t + 16 * s + 8 * hh), Sb[t][s], WS);
                float vn[16];
#pragma unroll
                for (int r = 0; r < 16; ++r) { const unsigned uw = ucur[(i * 16 + r) >> 3][((i * 16 + r) >> 1) & 3]; vn[r] = ((r & 1) ? bfhi(uw) : bflo(uw)) - WS[r]; }
#pragma unroll
                for (int s = 0; s < 2; ++s) Vb[i][s] = pack8(vn[8 * s], vn[8 * s + 1], vn[8 * s + 2], vn[8 * s + 3], vn[8 * s + 4], vn[8 * s + 5], vn[8 * s + 6], vn[8 * s + 7]);
            }
            f32x16 O[2];
#pragma unroll
            for (int ip = 0; ip < 2; ++ip) {
#pragma unroll
                for (int r = 0; r < 16; ++r) O[ip][r] = 0.f;
#pragma unroll
                for (int t = 0; t < 4; ++t)
#pragma unroll
                    for (int s = 0; s < 2; ++s) O[ip] = MFMA32(ldfrag(Ql, 136, 32 * ip + n, 32 * t + 16 * s + 8 * hh), Sb[t][s], O[ip]);
#pragma unroll
                for (int r = 0; r < 16; ++r) O[ip][r] *= __expf(gc[32 * ip + crow(r, hh)]);
#pragma unroll
                for (int i = 0; i <= ip; ++i)
#pragma unroll
                    for (int s = 0; s < 2; ++s) O[ip] = MFMA32(ldfrag(QKl, 72, 32 * ip + n, 32 * i + 16 * s + 8 * hh), Vb[i][s], O[ip]);
            }
            const float gt = __expf(gc[63]);
            __syncthreads();
#pragma unroll
            for (int ip = 0; ip < 2; ++ip)
#pragma unroll
                for (int r = 0; r < 16; ++r) Os[(32 * ip + crow(r, hh)) * 132 + dv0 + n] = O[ip][r];
#pragma unroll
            for (int t = 0; t < 4; ++t) {
#pragma unroll
                for (int r = 0; r < 16; ++r) S[t][r] *= gt;
#pragma unroll
                for (int i = 0; i < 2; ++i)
#pragma unroll
                    for (int s = 0; s < 2; ++s) S[t] = MFMA32(ldfrag(KDl, 72, 32 * t + n, 32 * i + 16 * s + 8 * hh), Vb[i][s], S[t]);
            }
#pragma unroll
            for (int j = 0; j < 4; ++j) ucur[j] = unext[j];
            __syncthreads();
        }
        __syncthreads();
    } else {
        const int lt = F.tid - 256, nrow = lt >> 2, nseg = lt & 3;
        u32x4 pre[14]; f32x4 pg = {0.f, 0.f, 0.f, 0.f};
        float ov[32]; float rstd = 0.f;
#define GDN_ISSUE(cc) do { const int row0_ = rowb + (cc) * 64; const int unit_ = (b * 128 + (cc)) * 4 + h; \
            _Pragma("unroll") for (int j = 0; j < 4; ++j) { const int id = lt + 256 * j; pre[j] = *(const u32x4*)(PROJ + (size_t)(row0_ + (id >> 4)) * NPROJ + PC_K + h * 128 + (id & 15) * 8); \
                pre[4 + j] = *(const u32x4*)(PROJ + (size_t)(row0_ + (id >> 4)) * NPROJ + PC_Q + h * 128 + (id & 15) * 8); \
                pre[10 + j] = *(const u32x4*)(KDTa + (size_t)unit_ * 8192 + id * 8); } \
            _Pragma("unroll") for (int j = 0; j < 2; ++j) { const int id = lt + 256 * j; pre[8 + j] = *(const u32x4*)(QKa + (size_t)unit_ * 4096 + id * 8); } \
            if (lt < 16) pg = *(const f32x4*)(GC + (cc) * 64 + lt * 4); } while (0)
#define GDN_WRITE(cc) do { LAS unsigned char* bb = F.lds + ((cc) & 1) * BUFB; \
            _Pragma("unroll") for (int j = 0; j < 4; ++j) { const int id = lt + 256 * j; *(LAS u32x4*)(bb + (id >> 4) * 272 + (id & 15) * 16) = pre[j]; \
                *(LAS u32x4*)(bb + OFF_Q + (id >> 4) * 272 + (id & 15) * 16) = pre[4 + j]; \
                *(LAS u32x4*)(bb + OFF_KD + (id >> 3) * 144 + (id & 7) * 16) = pre[10 + j]; } \
            _Pragma("unroll") for (int j = 0; j < 2; ++j) { const int id = lt + 256 * j; *(LAS u32x4*)(bb + OFF_QK + (id >> 3) * 144 + (id & 7) * 16) = pre[8 + j]; } \
            if (lt < 16) *(LAS f32x4*)(gcs + ((cc) & 1) * 64 + lt * 4) = pg; } while (0)
#define GDN_READ_OS() do { const LAS float* orow = Os + nrow * 132 + nseg * 32; float ss = 0.f; \
            _Pragma("unroll") for (int j4 = 0; j4 < 8; ++j4) { const f32x4 v = *(const LAS f32x4*)(orow + 4 * j4); ov[4 * j4] = v[0]; ov[4 * j4 + 1] = v[1]; ov[4 * j4 + 2] = v[2]; ov[4 * j4 + 3] = v[3]; ss += v[0] * v[0] + v[1] * v[1] + v[2] * v[2] + v[3] * v[3]; } \
            ss += __shfl_xor(ss, 1); ss += __shfl_xor(ss, 2); rstd = rsqrtf(ss * (1.f / 128.f) + 1e-6f); } while (0)
#define GDN_NORM_STORE(cc) do { bf16_t* zp = PROJ + (size_t)(rowb + (cc) * 64 + nrow) * NPROJ + PC_GZ + h * 128 + nseg * 32; const float* nwp = a.in[9] + l * 128 + nseg * 32; \
            _Pragma("unroll") for (int j = 0; j < 4; ++j) { const u32x4 zv = *(const u32x4*)(zp + 8 * j); const unsigned zz[4] = {zv.x, zv.y, zv.z, zv.w}; unsigned oo[4]; \
                _Pragma("unroll") for (int e = 0; e < 4; ++e) oo[e] = pk2(ov[8 * j + 2 * e] * rstd * nwp[8 * j + 2 * e] * silu_f(bflo(zz[e])), ov[8 * j + 2 * e + 1] * rstd * nwp[8 * j + 2 * e + 1] * silu_f(bfhi(zz[e]))); \
                *(u32x4*)(zp + 8 * j) = (u32x4){oo[0], oo[1], oo[2], oo[3]}; } } while (0)
        GDN_ISSUE(0); GDN_WRITE(0);
        __syncthreads();
        for (int c = 0; c < 128; ++c) {
            if (c + 1 < 128) GDN_ISSUE(c + 1);
            if (c > 0) GDN_READ_OS();
            __syncthreads();
            if (c > 0) GDN_NORM_STORE(c - 1);
            if (c + 1 < 128) GDN_WRITE(c + 1);
            __syncthreads();
        }
        GDN_READ_OS();
        GDN_NORM_STORE(127);
        __syncthreads();
#undef GDN_ISSUE
#undef GDN_WRITE
#undef GDN_READ_OS
#undef GDN_NORM_STORE
    }
}

DI void ssd_pass_a(const Ctx& F, const Args& a, int l, int unit) {
    const int h = unit & 7, seg = (unit >> 3) & 15, b = unit >> 7, g = h >> 2;
    const int w = F.wave, lane = F.lane, tid = F.tid, fr = lane & 15, q = lane >> 4;
    const bf16_t* PROJ = (const bf16_t*)(a.ws + WS_PROJ);
    LAS bf16_t* XTs = (LAS bf16_t*)F.lds;
    LAS bf16_t* BTs = (LAS bf16_t*)(F.lds + 9216);
    LAS float* dt_s = (LAS float*)(F.lds + 27648);
    LAS float* ac_s = (LAS float*)(F.lds + 27904);
    f32x4 ST[4];
#pragma unroll
    for (int j = 0; j < 4; ++j) ST[j] = (f32x4){0.f, 0.f, 0.f, 0.f};
    int pcol = 0, cch = 0;
    if (tid < 64) { pcol = PC_SX + h * 64 + tid; cch = h * 64 + tid; } else if (tid < 192) { pcol = PC_BM + g * 128 + (tid - 64); cch = 512 + g * 128 + (tid - 64); }
    float cw[4] = {0.f, 0.f, 0.f, 0.f}, cbias = 0.f, pv[3] = {0.f, 0.f, 0.f};
    const int rseg = b * SEQ + seg * 512;
    if (tid < 192) {
#pragma unroll
        for (int k = 0; k < 4; ++k) cw[k] = a.in[10][(size_t)(l * 4 + k) * 1024 + cch];
        cbias = a.in[11][l * 1024 + cch];
        if (seg > 0) {
#pragma unroll
            for (int i = 0; i < 3; ++i) pv[i] = bf2f(PROJ[(size_t)(rseg - 3 + i) * NPROJ + pcol]);
        }
    }
    const float dtb = a.in[13][l * 8 + h], negA = -__expf(a.in[12][l * 8 + h]);
    float ltot = 0.f;
    for (int ch = 0; ch < 8; ++ch) {
        const int rowc = rseg + ch * 64;
        if (w == 3) {
            const float dtv = softplus_f(((const float*)(a.ws + WS_SMALL))[(size_t)(rowc + lane) * 16 + 8 + h] + dtb);
            const float ac = wave_incl_scan(dtv * negA, lane);
            dt_s[lane] = dtv; ac_s[lane] = ac;
        }
        __syncthreads();
        if (tid < 192) {
            const float al = ac_s[63];
            float prev = 0.f;
#pragma unroll 8
            for (int i = 0; i < 64; ++i) {
                const float x = bf2f(PROJ[(size_t)(rowc + i) * NPROJ + pcol]);
                float y = cw[0] * pv[0] + cw[1] * pv[1] + cw[2] * pv[2] + cw[3] * x + cbias;
                pv[0] = pv[1]; pv[1] = pv[2]; pv[2] = x;
                y = silu_f(y);
                if (tid < 64) y *= dt_s[i] * __expf(al - ac_s[i]);
                if (i & 1) { if (tid < 64) *(LAS unsigned*)(XTs + tid * 72 + i - 1) = pk2(prev, y); else *(LAS unsigned*)(BTs + (tid - 64) * 72 + i - 1) = pk2(prev, y); }
                prev = y;
            }
        }
        __syncthreads();
        {
            const float dc = __expf(ac_s[63]);
            ltot += ac_s[63];
#pragma unroll
            for (int pj = 0; pj < 4; ++pj) {
                ST[pj] = ST[pj] * dc;
#pragma unroll
                for (int s2 = 0; s2 < 2; ++s2) ST[pj] = MFMA16(ldfrag(BTs, 72, 16 * w + fr, 32 * s2 + 8 * q), ldfrag(XTs, 72, 16 * pj + fr, 32 * s2 + 8 * q), ST[pj]);
            }
        }
        __syncthreads();
    }
    float* SS = (float*)(a.ws + WS_SSEG) + (size_t)unit * 8192;
#pragma unroll
    for (int pj = 0; pj < 4; ++pj)
#pragma unroll
        for (int r = 0; r < 4; ++r) SS[(16 * w + 4 * q + r) * 64 + 16 * pj + fr] = ST[pj][r];
    if (tid == 0) ((float*)(a.ws + WS_LSEG))[unit] = ltot;
}

DI void ssd_pass_c(const Ctx& F, const Args& a, int l, int unit) {
    const int seg = unit & 15, g = (unit >> 4) & 1, b = unit >> 5;
    const int w = F.wave, lane = F.lane, tid = F.tid, fr = lane & 15, q = lane >> 4, hd = w >> 1, e2 = w & 1, head = g * 4 + hd;
    bf16_t* PROJ = (bf16_t*)(a.ws + WS_PROJ);
    LAS bf16_t* Cs = (LAS bf16_t*)F.lds;
    LAS bf16_t* Bs = (LAS bf16_t*)(F.lds + 17408);
    LAS bf16_t* BTs = (LAS bf16_t*)(F.lds + 34816);
    LAS bf16_t* XTs = (LAS bf16_t*)(F.lds + 53248);
    LAS float* CBs = (LAS float*)(F.lds + 90112);
    LAS float* dt_s = (LAS float*)(F.lds + 107520);
    LAS float* ac_s = (LAS float*)(F.lds + 108544);
    LAS float* rss = (LAS float*)(F.lds + 109568);
    f32x4 ST[8][2];
#pragma unroll
    for (int si = 0; si < 8; ++si)
#pragma unroll
        for (int pl = 0; pl < 2; ++pl) ST[si][pl] = (f32x4){0.f, 0.f, 0.f, 0.f};
    for (int j = 0; j < seg; ++j) {
        const int ua = (b * 16 + j) * 8 + head;
        const float dcj = __expf(((const float*)(a.ws + WS_LSEG))[ua]);
        const float* SS = (const float*)(a.ws + WS_SSEG) + (size_t)ua * 8192;
#pragma unroll
        for (int si = 0; si < 8; ++si)
#pragma unroll
            for (int pl = 0; pl < 2; ++pl)
#pragma unroll
                for (int r = 0; r < 4; ++r) ST[si][pl][r] = ST[si][pl][r] * dcj + SS[(16 * si + 4 * q + r) * 64 + 16 * (2 * e2 + pl) + fr];
    }
    int pcol, cch;
    if (tid < 256) { pcol = PC_SX + g * 256 + tid; cch = g * 256 + tid; } else if (tid < 384) { pcol = PC_BM + g * 128 + (tid - 256); cch = 512 + g * 128 + (tid - 256); } else { pcol = PC_CM + g * 128 + (tid - 384); cch = 768 + g * 128 + (tid - 384); }
    float cw[4], pv[3] = {0.f, 0.f, 0.f};
#pragma unroll
    for (int k = 0; k < 4; ++k) cw[k] = a.in[10][(size_t)(l * 4 + k) * 1024 + cch];
    const float cbias = a.in[11][l * 1024 + cch];
    const int rseg = b * SEQ + seg * 512;
    if (seg > 0) {
#pragma unroll
        for (int i = 0; i < 3; ++i) pv[i] = bf2f(PROJ[(size_t)(rseg - 3 + i) * NPROJ + pcol]);
    }
    const float dskip = a.in[14][l * 8 + head];
    float nwv[2]; nwv[0] = a.in[15][l * 512 + g * 256 + hd * 64 + 16 * (2 * e2) + fr]; nwv[1] = a.in[15][l * 512 + g * 256 + hd * 64 + 16 * (2 * e2 + 1) + fr];
    for (int ch = 0; ch < 8; ++ch) {
        const int rowc = rseg + ch * 64;
        if (w < 4) {
            const int hw = g * 4 + w;
            const float dtv = softplus_f(((const float*)(a.ws + WS_SMALL))[(size_t)(rowc + lane) * 16 + 8 + hw] + a.in[13][l * 8 + hw]);
            const float ac = wave_incl_scan(dtv * (-__expf(a.in[12][l * 8 + hw])), lane);
            dt_s[w * 64 + lane] = dtv; ac_s[w * 64 + lane] = ac;
        }
        {
#pragma unroll 8
            for (int i = 0; i < 64; ++i) {
                const float x = bf2f(PROJ[(size_t)(rowc + i) * NPROJ + pcol]);
                float y = cw[0] * pv[0] + cw[1] * pv[1] + cw[2] * pv[2] + cw[3] * x + cbias;
                pv[0] = pv[1]; pv[1] = pv[2]; pv[2] = x;
                const bf16_t yb = (bf16_t)f2bf(silu_f(y));
                if (tid < 256) XTs[tid * 72 + i] = yb;
                else if (tid < 384) { Bs[i * 136 + (tid - 256)] = yb; BTs[(tid - 256) * 72 + i] = yb; }
                else Cs[i * 136 + (tid - 384)] = yb;
            }
        }
        __syncthreads();
        {
            const int ci = w >> 1;
#pragma unroll
            for (int ee = 0; ee < 2; ++ee) {
                const int ej = 2 * (w & 1) + ee; f32x4 acc = {0.f, 0.f, 0.f, 0.f};
#pragma unroll
                for (int s = 0; s < 4; ++s) acc = MFMA16(ldfrag(Bs, 136, 16 * ej + fr, 32 * s + 8 * q), ldfrag(Cs, 136, 16 * ci + fr, 32 * s + 8 * q), acc);
                *(LAS f32x4*)(CBs + (16 * ci + fr) * 68 + 16 * ej + 4 * q) = acc;
            }
        }
        f32x4 Y[4][2];
        {
            bf16x8 STb[2][4];
#pragma unroll
            for (int pl = 0; pl < 2; ++pl)
#pragma unroll
                for (int s4 = 0; s4 < 4; ++s4) STb[pl][s4] = pack8(ST[2 * s4][pl][0], ST[2 * s4][pl][1], ST[2 * s4][pl][2], ST[2 * s4][pl][3], ST[2 * s4 + 1][pl][0], ST[2 * s4 + 1][pl][1], ST[2 * s4 + 1][pl][2], ST[2 * s4 + 1][pl][3]);
#pragma unroll
            for (int ci = 0; ci < 4; ++ci)
#pragma unroll
                for (int pl = 0; pl < 2; ++pl) {
                    f32x4 acc = {0.f, 0.f, 0.f, 0.f};
#pragma unroll
                    for (int s4 = 0; s4 < 4; ++s4) acc = MFMA16(ldfrag_perm16(Cs, 136, 16 * ci + fr, s4, q), STb[pl][s4], acc);
#pragma unroll
                    for (int r = 0; r < 4; ++r) acc[r] *= __expf(ac_s[hd * 64 + 16 * ci + 4 * q + r]);
                    Y[ci][pl] = acc;
                }
        }
        __syncthreads();
        {
            const LAS float* ach = ac_s + hd * 64; const LAS float* dth = dt_s + hd * 64;
#pragma unroll
            for (int ci = 0; ci < 4; ++ci) {
                asm volatile("" ::: "memory");
                const int cc = 16 * ci + fr; const float acc_c = ach[cc];
#pragma unroll
                for (int s2 = 0; s2 < 2; ++s2) {
                    const int e0 = 32 * s2 + 8 * q; float gv[8];
                    const f32x4 c0 = *(const LAS f32x4*)(CBs + cc * 68 + e0), c1 = *(const LAS f32x4*)(CBs + cc * 68 + e0 + 4);
#pragma unroll
                    for (int j = 0; j < 8; ++j) { const int e = e0 + j; const float cbv = j < 4 ? c0[j & 3] : c1[j & 3]; gv[j] = (e <= cc) ? cbv * __expf(acc_c - ach[e]) * dth[e] : 0.f; }
                    const bf16x8 Gf = pack8(gv[0], gv[1], gv[2], gv[3], gv[4], gv[5], gv[6], gv[7]);
#pragma unroll
                    for (int pl = 0; pl < 2; ++pl) Y[ci][pl] = MFMA16(Gf, ldfrag(XTs, 72, hd * 64 + 16 * (2 * e2 + pl) + fr, e0), Y[ci][pl]);
                }
            }
            const float al = ach[63], dc = __expf(al);
            float scv[2][8];
#pragma unroll
            for (int s2 = 0; s2 < 2; ++s2)
#pragma unroll
                for (int j = 0; j < 8; ++j) { const int cidx = 32 * s2 + 8 * q + j; scv[s2][j] = dth[cidx] * __expf(al - ach[cidx]); }
#pragma unroll
            for (int si = 0; si < 8; ++si) {
                asm volatile("" ::: "memory");
                ST[si][0] = ST[si][0] * dc; ST[si][1] = ST[si][1] * dc;
#pragma unroll
                for (int s2 = 0; s2 < 2; ++s2) {
                    const u32x4 bv = *(const LAS u32x4*)(BTs + (16 * si + fr) * 72 + 32 * s2 + 8 * q);
                    const bf16x8 Bf = pack8(bflo(bv.x) * scv[s2][0], bfhi(bv.x) * scv[s2][1], bflo(bv.y) * scv[s2][2], bfhi(bv.y) * scv[s2][3], bflo(bv.z) * scv[s2][4], bfhi(bv.z) * scv[s2][5], bflo(bv.w) * scv[s2][6], bfhi(bv.w) * scv[s2][7]);
#pragma unroll
                    for (int pl = 0; pl < 2; ++pl) ST[si][pl] = MFMA16(Bf, ldfrag(XTs, 72, hd * 64 + 16 * (2 * e2 + pl) + fr, 32 * s2 + 8 * q), ST[si][pl]);
                }
            }
        }
        {
            float part[4][4];
#pragma unroll
            for (int ci = 0; ci < 4; ++ci)
#pragma unroll
                for (int r = 0; r < 4; ++r) {
                    const int cc = 16 * ci + 4 * q + r; float ps = 0.f;
#pragma unroll
                    for (int pl = 0; pl < 2; ++pl) {
                        const int p = 16 * (2 * e2 + pl) + fr;
                        const float x = bf2f(XTs[(hd * 64 + p) * 72 + cc]);
                        const float z = bf2f(PROJ[(size_t)(rowc + cc) * NPROJ + PC_SZ + g * 256 + hd * 64 + p]);
                        const float gz = (Y[ci][pl][r] + dskip * x) * silu_f(z);
                        Y[ci][pl][r] = gz; ps += gz * gz;
                    }
                    ps += __shfl_xor(ps, 1); ps += __shfl_xor(ps, 2); ps += __shfl_xor(ps, 4); ps += __shfl_xor(ps, 8);
                    part[ci][r] = ps;
                }
            if (fr == 0) {
#pragma unroll
                for (int ci = 0; ci < 4; ++ci)
#pragma unroll
                    for (int r = 0; r < 4; ++r) rss[w * 64 + 16 * ci + 4 * q + r] = part[ci][r];
            }
            __syncthreads();
#pragma unroll
            for (int ci = 0; ci < 4; ++ci)
#pragma unroll
                for (int r = 0; r < 4; ++r) {
                    const int cc = 16 * ci + 4 * q + r; float tot = 0.f;
#pragma unroll
                    for (int ww = 0; ww < 8; ++ww) tot += rss[ww * 64 + cc];
                    const float rstd = rsqrtf(tot * (1.f / 256.f) + 1e-6f);
#pragma unroll
                    for (int pl = 0; pl < 2; ++pl) {
                        const int p = 16 * (2 * e2 + pl) + fr;
                        PROJ[(size_t)(rowc + cc) * NPROJ + PC_SZ + g * 256 + hd * 64 + p] = (bf16_t)f2bf(Y[ci][pl][r] * rstd * nwv[pl]);
                    }
                }
        }
        __syncthreads();
    }
}

template <bool FINAL>
DI void lru_pass(const Ctx& F, const Args& a, int l, int unit) {
    const int blk = unit & 7, seg = (unit >> 3) & 15, b = unit >> 7;
    const int w = F.wave, lane = F.lane, tid = F.tid, fr = lane & 15, q = lane >> 4;
    bf16_t* PROJ = (bf16_t*)(a.ws + WS_PROJ);
    LAS bf16_t* WAT = (LAS bf16_t*)F.lds;
    LAS bf16_t* WXT = (LAS bf16_t*)(F.lds + 9216);
    LAS bf16_t* XCs = (LAS bf16_t*)(F.lds + 18432);
    LAS float* XF = (LAS float*)(F.lds + 27648);
    LAS float* As = (LAS float*)(F.lds + 44288);
    LAS float* Us = (LAS float*)(F.lds + 60928);
    for (int e8 = tid; e8 < 4096; e8 += 512) {
        const int d = e8 >> 6, e = e8 & 63;
        WAT[e * 72 + d] = (bf16_t)f2bf(a.in[18][((size_t)(l * 8 + blk) * 64 + d) * 64 + e]);
        WXT[e * 72 + d] = (bf16_t)f2bf(a.in[20][((size_t)(l * 8 + blk) * 64 + d) * 64 + e]);
    }
    const int chn = blk * 64 + (tid & 63);
    float cw[4] = {0.f, 0.f, 0.f, 0.f}, cbias = 0.f, pv[3] = {0.f, 0.f, 0.f};
    const int rseg = b * SEQ + seg * 512;
    if (tid < 64) {
#pragma unroll
        for (int k = 0; k < 4; ++k) cw[k] = a.in[16][(size_t)(l * 4 + k) * 512 + chn];
        cbias = a.in[17][l * 512 + chn];
        if (seg > 0) {
#pragma unroll
            for (int i = 0; i < 3; ++i) pv[i] = bf2f(PROJ[(size_t)(rseg - 3 + i) * NPROJ + PC_LX + chn]);
        }
    }
    float hcur = 0.f, pprod = 1.f;
    if (FINAL && w == 0) {
        for (int j = 0; j < seg; ++j) hcur = hcur * ((const float*)(a.ws + WS_LRUP))[(size_t)(b * 16 + j) * 512 + chn] + ((const float*)(a.ws + WS_LRUH))[(size_t)(b * 16 + j) * 512 + chn];
    }
    float ba[2], bx[2], spl[2];
#pragma unroll
    for (int ee = 0; ee < 2; ++ee) { const int ce = blk * 64 + 16 * (2 * (w >> 2) + ee) + fr; ba[ee] = a.in[19][l * 512 + ce]; bx[ee] = a.in[21][l * 512 + ce]; spl[ee] = softplus_f(-a.in[22][l * 512 + ce]); }
    __syncthreads();
    for (int ch = 0; ch < 8; ++ch) {
        const int rowc = rseg + ch * 64;
        if (tid < 64) {
#pragma unroll 8
            for (int i = 0; i < 64; ++i) {
                const float x = bf2f(PROJ[(size_t)(rowc + i) * NPROJ + PC_LX + chn]);
                const float y = cw[0] * pv[0] + cw[1] * pv[1] + cw[2] * pv[2] + cw[3] * x + cbias;
                pv[0] = pv[1]; pv[1] = pv[2]; pv[2] = x;
                XCs[i * 72 + tid] = (bf16_t)f2bf(y); XF[i * 65 + tid] = y;
            }
        }
        __syncthreads();
        {
            const int ci = w & 3;
#pragma unroll
            for (int ee = 0; ee < 2; ++ee) {
                const int ej = 2 * (w >> 2) + ee; f32x4 aa = {0.f, 0.f, 0.f, 0.f}, ax = {0.f, 0.f, 0.f, 0.f};
#pragma unroll
                for (int s = 0; s < 2; ++s) { const bf16x8 xf = ldfrag(XCs, 72, 16 * ci + fr, 32 * s + 8 * q);
                    aa = MFMA16(xf, ldfrag(WAT, 72, 16 * ej + fr, 32 * s + 8 * q), aa); ax = MFMA16(xf, ldfrag(WXT, 72, 16 * ej + fr, 32 * s + 8 * q), ax); }
#pragma unroll
                for (int r = 0; r < 4; ++r) {
                    const int cc = 16 * ci + 4 * q + r, e = 16 * ej + fr;
                    const float rg = sigmoid_f(aa[r] + ba[ee]), ig = sigmoid_f(ax[r] + bx[ee]);
                    const float la = -8.0f * rg * spl[ee];
                    As[cc * 65 + e] = __expf(la); Us[cc * 65 + e] = sqrtf(-expm1f(2.0f * la)) * ig * XF[cc * 65 + e];
                }
            }
        }
        __syncthreads();
        if (w == 0) {
#pragma unroll 8
            for (int i = 0; i < 64; ++i) { const float av = As[i * 65 + lane], uv = Us[i * 65 + lane]; hcur = av * hcur + uv; pprod *= av; if (FINAL) As[i * 65 + lane] = hcur; }
        }
        if (FINAL) {
            __syncthreads();
            const int cc = tid >> 3, e8 = (tid & 7) * 8;
            bf16_t* gp = PROJ + (size_t)(rowc + cc) * NPROJ + PC_LG + blk * 64 + e8;
            const u32x4 gv = *(const u32x4*)gp; const unsigned gg[4] = {gv.x, gv.y, gv.z, gv.w}; unsigned oo[4];
#pragma unroll
            for (int j = 0; j < 4; ++j) oo[j] = pk2(As[cc * 65 + e8 + 2 * j] * gelu_tanh_f(bflo(gg[j])), As[cc * 65 + e8 + 2 * j + 1] * gelu_tanh_f(bfhi(gg[j])));
            *(u32x4*)gp = (u32x4){oo[0], oo[1], oo[2], oo[3]};
        }
        __syncthreads();
    }
    if (!FINAL && w == 0) {
        ((float*)(a.ws + WS_LRUP))[(size_t)(b * 16 + seg) * 512 + chn] = pprod;
        ((float*)(a.ws + WS_LRUH))[(size_t)(b * 16 + seg) * 512 + chn] = hcur;
    }
}

__global__ void __launch_bounds__(512, 2) mega_fwd(Args args) {
    extern __shared__ __attribute__((aligned(16))) unsigned char lds_raw[];
    LAS unsigned char* const ldsp = (LAS unsigned char*)lds_raw;
#define F make_ctx(ldsp)
    const int lo = args.ph_lo, hi = args.ph_hi;
    unsigned char* ws = args.ws;
    float* MOD = (float*)(ws + WS_MOD);
    bf16_t* XN = (bf16_t*)(ws + WS_XN); bf16_t* PROJ = (bf16_t*)(ws + WS_PROJ); bf16_t* MERGED = (bf16_t*)(ws + WS_MERGED);
#define IN(k) (lo <= (k) && (k) < hi)
#define SEAM(k) do { if (IN(k) && IN((k) + 1)) { __threadfence(); cg::this_grid().sync(); } } while (0)
    if (IN(0)) { for (int rep = 0; rep < REP_B; ++rep) phase_p0(F, args); }
    SEAM(0);
#pragma unroll 1
    for (int l = 0; l < 2; ++l) {
        const int base = 1 + 9 * l;
        const float* modl = MOD + (size_t)l * 4 * 6144;
        const bf16_t* wl = (const bf16_t*)(ws + WS_W) + (size_t)l * WO_LAYER;
        const float* xcur = l == 0 ? args.in[0] : args.out;
        if (IN(base + 0)) for (int rep = 0; rep < REP_B; ++rep) phase_norm<true>(F, xcur, args.in[4] + l * DM, modl, 0, 1024, XN, (const float*)(ws + WS_WSM) + (size_t)l * 16 * 1024, (float*)(ws + WS_SMALL));
        SEAM(base + 0);
        if (IN(base + 1)) for (int rep = 0; rep < REP_A; ++rep) {
            pg8::Gemm g{XN, wl + WO_IN, MTOK, NPROJ, DM, DM, DM}; pg8::StaticOrder S; S.init(MTOK, NPROJ, F.G, F.bid);
            pg8::EpiProj E{PROJ, (bf16_t*)(ws + WS_TAIL)};
            pg8::gemm_phase(F.lds, g, S, E);
        }
        SEAM(base + 1);
        if (IN(base + 2)) {
            for (int u = F.bid; u < 3072; u += F.G) {
                if (u < 512) { for (int rep = 0; rep < REP_B; ++rep) ssd_pass_a(F, args, l, u); }
                else if (u < 1024) { for (int rep = 0; rep < REP_B; ++rep) lru_pass<false>(F, args, l, u - 512); }
                else gdn_prep_unit(F, args, l, u - 1024);
                __syncthreads();
            }
        }
        SEAM(base + 2);
        if (IN(base + 3)) {
            if (F.bid < 16) gdn_seq(F, args, l, F.bid);
            else {
                for (int u = F.bid - 16; u < 640; u += F.G - 16) {
                    if (u < 128) ssd_pass_c(F, args, l, u); else lru_pass<true>(F, args, l, u - 128);
                    __syncthreads();
                }
            }
        }
        SEAM(base + 3);
        if (IN(base + 4)) for (int rep = 0; rep < REP_A; ++rep) {
            pg8::StaticOrder S; S.init(MTOK, DM, F.G, F.bid);
#pragma unroll 1
            for (int r = 0; r < 3; ++r) {
                { pg8::Gemm g{XN, wl + WO_GATE + (size_t)r * DM * DM, MTOK, DM, DM, DM, DM}; pg8::EpiGate E{PROJ, NPROJ}; pg8::gemm_phase(F.lds, g, S, E); }
                __threadfence(); __syncthreads();
                const int ycol = r == 0 ? PC_GZ : (r == 1 ? PC_SZ : PC_LG);
                pg8::Gemm g{PROJ + ycol, wl + WO_BR + (size_t)r * DM * 512, MTOK, DM, 512, NPROJ, 512};
                if (r == 0) { pg8::EpiBranch<true> E{PROJ, NPROJ, MERGED}; pg8::gemm_phase(F.lds, g, S, E); }
                else { pg8::EpiBranch<false> E{PROJ, NPROJ, MERGED}; pg8::gemm_phase(F.lds, g, S, E); }
                __threadfence(); __syncthreads();
            }
        }
        SEAM(base + 4);
        if (IN(base + 5)) {
            pg8::Gemm g{MERGED, wl + WO_OUT, MTOK, DM, DM, DM, DM}; pg8::StaticOrder S; S.init(MTOK, DM, F.G, F.bid);
            pg8::EpiResid E{xcur, args.out, modl + 2048};
            pg8::gemm_phase(F.lds, g, S, E);
        }
        SEAM(base + 5);
        if (IN(base + 6)) for (int rep = 0; rep < REP_B; ++rep) phase_norm<false>(F, args.out, args.in[25] + l * DM, modl, 3072, 4096, XN, nullptr, nullptr);
        SEAM(base + 6);
        if (IN(base + 7)) for (int rep = 0; rep < REP_A; ++rep) {
            pg8::Gemm g{XN, wl + WO_UP, MTOK, DFF, DM, DM, DM}; pg8::StaticOrder S; S.init(MTOK, DFF, F.G, F.bid);
            pg8::EpiUp E{PROJ};
            pg8::gemm_phase(F.lds, g, S, E);
        }
        SEAM(base + 7);
        if (IN(base + 8)) {
            pg8::Gemm g{PROJ, wl + WO_DOWN, MTOK, DM, DFF, DFF, DFF}; pg8::StaticOrder S; S.init(MTOK, DM, F.G, F.bid);
            pg8::EpiResid E{args.out, args.out, modl + 5120};
            pg8::gemm_phase(F.lds, g, S, E);
        }
        SEAM(base + 8);
    }
    if (IN(19)) phase_final_norm(F, args.out, args.in[28]);
#undef IN
#undef SEAM
}

extern "C" void kernel_launch(void* const* d_in, const int* in_sizes, int n_in, void* d_out, int out_size, void* d_ws, size_t ws_size, hipStream_t stream) {
    static int grid = 0;
    if (grid == 0) {
        if (n_in != 29 || out_size != MTOK * DM || ws_size < WS_END) { fprintf(stderr, "kernel_launch: unexpected problem (n_in %d out %d ws %zu)\n", n_in, out_size, ws_size); grid = -1; return; }
        int dev = 0, cus = 0, per_cu = 0;
        hipGetDevice(&dev); hipDeviceGetAttribute(&cus, hipDeviceAttributeMultiprocessorCount, dev);
        if (hipFuncSetAttribute((const void*)mega_fwd, hipFuncAttributeMaxDynamicSharedMemorySize, LDS_BYTES) != hipSuccess) { fprintf(stderr, "kernel_launch: hipFuncSetAttribute failed\n"); grid = -1; return; }
        if (hipOccupancyMaxActiveBlocksPerMultiprocessor(&per_cu, (const void*)mega_fwd, 512, LDS_BYTES) != hipSuccess || per_cu < 1) { fprintf(stderr, "kernel_launch: occupancy query says %d\n", per_cu); per_cu = 1; }
        (void)hipGetLastError();
        grid = cus * per_cu;
    }
    if (grid < 0) return;
    Args a{};
    for (int i = 0; i < 29; ++i) a.in[i] = (const float*)d_in[i];
    a.out = (float*)d_out; a.ws = (unsigned char*)d_ws;
#if MK_SINGLE
    a.ph_lo = 0; a.ph_hi = 20;
    void* kargs[] = {&a};
    hipError_t e = hipLaunchCooperativeKernel((const void*)mega_fwd, dim3(grid), dim3(512), kargs, LDS_BYTES, stream);
    if (e != hipSuccess) fprintf(stderr, "cooperative launch failed: %s (grid %d)\n", hipGetErrorString(e), grid);
#else
    for (int p = 0; p < 20; ++p) {
        a.ph_lo = p; a.ph_hi = p + 1;
        hipLaunchKernelGGL(mega_fwd, dim3(grid), dim3(512), LDS_BYTES, stream, a);
    }
#endif
}
```

```cpp
#include <hip/hip_runtime.h>
#include <hip/hip_cooperative_groups.h>
#include <cstdio>
#include <cstdint>
namespace cg = cooperative_groups;

#define LAS __attribute__((address_space(3)))
typedef unsigned short bf16_t;
typedef short bf16x8 __attribute__((ext_vector_type(8)));
typedef short s16x4 __attribute__((ext_vector_type(4)));
typedef float f32x4 __attribute__((ext_vector_type(4)));
typedef float f32x16 __attribute__((ext_vector_type(16)));
typedef unsigned u32x4 __attribute__((ext_vector_type(4)));
typedef unsigned u32x2 __attribute__((ext_vector_type(2)));
#define DI __device__ __forceinline__

#ifndef REP_A
#define REP_A 1
#endif
#ifndef REP_B
#define REP_B 1
#endif
#ifndef PROBE_A
#define PROBE_A -1
#define PROBE_B -1
#endif
#define PROBE_K 4
#ifndef PROBE_BLK
#define PROBE_BLK 0
#endif
#ifndef MK_SINGLE
#define MK_SINGLE 1
#endif

constexpr int DM = 1024, SEQ = 8192, MTOK = 32768, NPROJ = 4608, DFF = 4096, DIN = 7696;
constexpr int PC_Q = 0, PC_K = 512, PC_V = 1024, PC_GZ = 1536, PC_SX = 2048, PC_SZ = 2560, PC_BM = 3072, PC_CM = 3328, PC_LX = 3584, PC_LG = 4096;
constexpr size_t MiB = 1u << 20;
constexpr size_t WS_MOD = 0;
constexpr size_t WS_WSM = 256 * 1024;
constexpr size_t WS_GC = 1 * MiB;
constexpr size_t WS_LSEG = 1 * MiB + 512 * 1024;
constexpr size_t WS_LRUP = WS_LSEG + 4096;
constexpr size_t WS_LRUH = WS_LRUP + 128 * 1024;
constexpr size_t WS_SMALL = 2 * MiB;
constexpr size_t WS_TAIL = 4 * MiB;
constexpr size_t WS_W = 9 * MiB;
constexpr size_t WS_XN = 81 * MiB;
constexpr size_t WS_PROJ = 145 * MiB;
constexpr size_t WS_KDT = 433 * MiB;
constexpr size_t WS_QK = 465 * MiB;
constexpr size_t WS_SSEG = 481 * MiB;
constexpr size_t WS_MERGED = 433 * MiB;
constexpr size_t WS_END = 497 * MiB;
constexpr size_t WO_IN = 0, WO_GATE = 4718592, WO_BR = WO_GATE + 3145728, WO_OUT = WO_BR + 1572864, WO_UP = WO_OUT + 1048576, WO_DOWN = WO_UP + 4194304, WO_LAYER = WO_DOWN + 4194304;
constexpr int LDS_BYTES = 163840;

typedef float f32x2_t __attribute__((ext_vector_type(2)));
typedef __bf16 bf16x2_t __attribute__((ext_vector_type(2)));
DI unsigned pk2(float lo, float hi) { f32x2_t v; v.x = lo; v.y = hi; return __builtin_bit_cast(unsigned, __builtin_convertvector(v, bf16x2_t)); }
DI unsigned f2bf(float f) { return pk2(f, 0.f) & 0xffffu; }
DI float bf2f(unsigned short v) { return __builtin_bit_cast(float, (unsigned)v << 16); }
DI float bflo(unsigned v) { return __builtin_bit_cast(float, v << 16); }
DI float bfhi(unsigned v) { return __builtin_bit_cast(float, v & 0xffff0000u); }
DI float sigmoid_f(float x) { return __builtin_amdgcn_rcpf(1.f + __expf(-x)); }
DI float silu_f(float x) { return x * __builtin_amdgcn_rcpf(1.f + __expf(-x)); }
DI float softplus_f(float x) { return fmaxf(x, 0.f) + __logf(1.f + __expf(-fabsf(x))); }
DI float neg_expm1_small(float x) { return -x * (1.f + x * (0.5f + x * (0.16666667f + x * (0.041666668f + x * 0.0083333333f)))); }
DI float gelu_tanh_f(float x) { const float u = 0.7978845608028654f * (x + 0.044715f * x * x * x); const float t = 1.f - 2.f * __builtin_amdgcn_rcpf(1.f + __expf(2.f * u)); return 0.5f * x * (1.f + t); }
DI float wave_sum(float v) {
#pragma unroll
    for (int o = 1; o < 64; o <<= 1) v += __shfl_xor(v, o);
    return v;
}
DI float wave_incl_scan(float v, int lane) {
#pragma unroll
    for (int o = 1; o < 64; o <<= 1) { const float t = __shfl_up(v, o); if (lane >= o) v += t; }
    return v;
}
DI bf16x8 pack8(float a0, float a1, float a2, float a3, float a4, float a5, float a6, float a7) {
    u32x4 p; p.x = pk2(a0, a1); p.y = pk2(a2, a3); p.z = pk2(a4, a5); p.w = pk2(a6, a7); return __builtin_bit_cast(bf16x8, p);
}
DI bf16x8 cat4(s16x4 lo, s16x4 hi) { return __builtin_shufflevector(lo, hi, 0, 1, 2, 3, 4, 5, 6, 7); }
#define MFMA16(a, b, c) __builtin_amdgcn_mfma_f32_16x16x32_bf16((a), (b), (c), 0, 0, 0)
#define MFMA32(a, b, c) __builtin_amdgcn_mfma_f32_32x32x16_bf16((a), (b), (c), 0, 0, 0)
DI bf16x8 ldfrag(const LAS bf16_t* base, int pitch, int row, int k0) { return *(const LAS bf16x8*)(base + row * pitch + k0); }
DI bf16x8 ldfrag_perm16(const LAS bf16_t* base, int pitch, int row, int s, int q) {
    const LAS bf16_t* p = base + row * pitch + 32 * s + 4 * q; return cat4(*(const LAS s16x4*)p, *(const LAS s16x4*)(p + 16));
}
DI s16x4 ldg8(const void* base, unsigned off) { return *(const s16x4*)((const char*)base + off); }
DI bf16x8 ldg8x2(const void* base, unsigned off) { return cat4(ldg8(base, off), ldg8(base, off + 16u)); }
DI int crow(int r, int hh) { return (r & 3) + 8 * (r >> 2) + 4 * hh; }

#define GDN_BAR() do { asm volatile("s_waitcnt lgkmcnt(0)" ::: "memory"); __builtin_amdgcn_s_barrier(); asm volatile("" ::: "memory"); } while (0)
#define SCHEDB() __builtin_amdgcn_sched_barrier(0)
struct Ctx { LAS unsigned char* lds; int tid, lane, wave, G, bid; };
DI Ctx make_ctx(LAS unsigned char* lds) { Ctx F; int t = threadIdx.x; asm volatile("" : "+v"(t)); F.lds = lds; F.tid = t; F.lane = t & 63; F.wave = __builtin_amdgcn_readfirstlane(t >> 6); F.G = gridDim.x; F.bid = blockIdx.x; return F; }
struct Args { const float* in[29]; float* out; unsigned char* ws; int ph_lo, ph_hi; };

namespace pg8 {
constexpr int BM = 256, BK = 64, HALF = 128, HTB = HALF * BK * 2, STAGE_BYTES = 8 * HTB, NXCD = 8, WGM = 8;
DI int lds_byte(int r, int c) { const int st = (r >> 4) * 2 + (c >> 5), rr = r & 15, cc = c & 31, ob = rr * 64 + cc * 2; return st * 1024 + (ob ^ (((ob >> 9) & 1) << 5)); }
DI int perm32(int rho) { const int n = rho >> 4, i = rho & 15; return 8 * (i >> 2) + 4 * n + (i & 3); }
DI void stage_rc(int b, int& R, int& C) { const int st = b / 1024, sb = b % 1024, swz = sb ^ (((sb >> 9) & 1) << 5); R = (st >> 1) * 16 + swz / 64; C = (st & 1) * 32 + (swz % 64) / 2; }
struct Unit { int pm, pn, r; long aoff, boff; };
struct Gemm { const bf16_t* A; const bf16_t* Bt; int M, N, K, lda, ldb; };
struct StaticOrder {
    int nM, nN, nwg, G, c;
    DI void init(int M, int N, int G_, int c_) { nM = M / BM; nN = N / BM; nwg = nM * nN; G = G_; c = c_; }
    DI bool next(int i, Unit& u) const {
        const long L = (long)i * G + c; if (L >= nwg) return false;
        int wgid = (int)L; { const int q = nwg / NXCD, r = nwg % NXCD, xcd = wgid % NXCD, off = wgid / NXCD; wgid = (xcd < r ? xcd * (q + 1) : r * (q + 1) + (xcd - r) * q) + off; }
        const int nig = WGM * nN, gid = wgid / nig, fm = gid * WGM, gsz = (nM - fm) < WGM ? (nM - fm) : WGM;
        u.pm = fm + ((wgid % nig) % gsz); u.pn = (wgid % nig) / gsz; u.r = 0; u.aoff = 0; u.boff = 0; return true;
    }
};
struct GateOrder {
    StaticOrder so;
    DI bool next(int i, Unit& u) const { if (!so.next(i / 3, u)) return false; const int r = i % 3; u.r = r; u.pn = 4 * r + u.pn; return true; }
};
struct BranchOrder {
    StaticOrder so;
    DI bool next(int i, Unit& u) const { if (!so.next(i / 3, u)) return false; const int r = i % 3; u.r = r;
        u.aoff = (long)(r == 0 ? PC_GZ : (r == 1 ? PC_SZ : PC_LG)) * 2; u.boff = (long)r * DM * 512 * 2; return true; }
};
template <class Epi, class Sched>
DI void gemm_phase(LAS unsigned char* lds, const Gemm g, const Sched& S, const Epi& E) {
    int tid_ = threadIdx.x; asm volatile("" : "+v"(tid_)); const int tid = tid_, wid = __builtin_amdgcn_readfirstlane(tid >> 6), lane = tid & 63, wr = wid >> 2, wc = wid & 3, fr = lane & 15, fq = lane >> 4;
    const int K = g.K, nt = K / BK;
    unsigned voffA[2], voffB[2];
#pragma unroll
    for (int i = 0; i < 2; ++i) { int R, C; stage_rc(tid * 16 + i * 8192, R, C); const int Rb = (R & ~31) + perm32(R & 31); voffA[i] = (unsigned)(R * g.lda + C) * 2u; voffB[i] = (unsigned)(Rb * g.ldb + C) * 2u; }
    const size_t kstep = (size_t)(BK * 2);
    const size_t hstepA = (size_t)HALF * g.lda * 2, hstepB = (size_t)HALF * g.ldb * 2;
    const size_t tstepA = 2 * hstepA, tstepB = 2 * hstepB;
    const unsigned ldsw = (unsigned)wid * 1024u;
    const int aoff = lds_byte(wr * 64 + fr, fq * 8), boff = lds_byte(wc * 32 + fr, fq * 8);
#define PG8_SA(b, h) (((b) * 2 + (h)) * HTB)
#define PG8_SB(b, h) ((4 + (b) * 2 + (h)) * HTB)
#define PG8_STAGE(bufoff, gbase, voff) do { _Pragma("unroll") for (int _i = 0; _i < 2; ++_i) \
        __builtin_amdgcn_global_load_lds((const unsigned*)((const char*)(gbase) + (voff)[_i]), (LAS unsigned*)(lds + (bufoff) + ldsw + _i * 8192), 16, 0, 0); } while (0)
#define PG8_LDA(dst, b, h) do { _Pragma("unroll") for (int m = 0; m < 4; ++m) _Pragma("unroll") for (int k = 0; k < 2; ++k) dst[m][k] = *(const LAS bf16x8*)(lds + PG8_SA(b, h) + aoff + m * 2048 + k * 1024); } while (0)
#define PG8_LDB(dst, b, h) do { _Pragma("unroll") for (int n = 0; n < 2; ++n) _Pragma("unroll") for (int k = 0; k < 2; ++k) dst[n][k] = *(const LAS bf16x8*)(lds + PG8_SB(b, h) + boff + n * 2048 + k * 1024); } while (0)
#define PG8_MMA(ai, bj, At, Bt) do { __builtin_amdgcn_s_setprio(1); _Pragma("unroll") for (int m = 0; m < 4; ++m) _Pragma("unroll") for (int n = 0; n < 2; ++n) _Pragma("unroll") for (int k = 0; k < 2; ++k) \
        acc[ai][bj][m][n] = __builtin_amdgcn_mfma_f32_16x16x32_bf16(Bt[n][k], At[m][k], acc[ai][bj][m][n], 0, 0, 0); __builtin_amdgcn_s_setprio(0); } while (0)
#define PG8_WAIT_V(n) asm volatile("s_waitcnt vmcnt(" #n ")" ::: "memory")
#define PG8_WAIT_L(n) asm volatile("s_waitcnt lgkmcnt(" #n ")" ::: "memory")
#define PG8_BAR __builtin_amdgcn_s_barrier()
#define PG8_SCHED __builtin_amdgcn_sched_barrier(0)
    Unit cur, nxt; int ui = 0;
    if (!S.next(0, cur)) return;
    f32x4 acc[2][2][4][2];
#pragma unroll
    for (int a = 0; a < 2; ++a)
#pragma unroll
        for (int b = 0; b < 2; ++b)
#pragma unroll
            for (int m = 0; m < 4; ++m)
#pragma unroll
                for (int n = 0; n < 2; ++n) acc[a][b][m][n] = (f32x4){0.f, 0.f, 0.f, 0.f};
    bf16x8 At[4][2], B0[2][2], B1[2][2];
    const char* cA = (const char*)g.A + (size_t)cur.pm * tstepA + cur.aoff; const char* cB = (const char*)g.Bt + (size_t)cur.pn * tstepB + cur.boff;
    PG8_STAGE(PG8_SB(0, 0), cB, voffB); PG8_STAGE(PG8_SB(0, 1), cB + hstepB, voffB); PG8_STAGE(PG8_SA(0, 0), cA, voffA); PG8_STAGE(PG8_SA(0, 1), cA + hstepA, voffA);
    if (wr == 1) PG8_BAR;
    PG8_WAIT_V(2); PG8_BAR;
    PG8_STAGE(PG8_SB(1, 0), cB + kstep, voffB); PG8_STAGE(PG8_SA(1, 0), cA + kstep, voffA); PG8_STAGE(PG8_SB(1, 1), cB + hstepB + kstep, voffB);
    PG8_WAIT_V(6); PG8_BAR;
    for (;;) {
        const bool has_next = S.next(ui + 1, nxt);
        const char* nA = has_next ? (const char*)g.A + (size_t)nxt.pm * tstepA + nxt.aoff : cA; const char* nB = has_next ? (const char*)g.Bt + (size_t)nxt.pn * tstepB + nxt.boff : cB;
        for (int t = 0; t < nt; t += 2) {
            const bool last = (t == nt - 2);
            const char* a1 = cA + (size_t)(t + 1) * kstep;
            const char* a2 = last ? nA : cA + (size_t)(t + 2) * kstep; const char* b2 = last ? nB : cB + (size_t)(t + 2) * kstep;
            const char* a3 = a2 + kstep; const char* b3 = b2 + kstep;
            PG8_LDB(B0, 0, 0); PG8_LDB(B1, 0, 1); PG8_SCHED; PG8_LDA(At, 0, 0); PG8_STAGE(PG8_SA(1, 1), a1 + hstepA, voffA);
            PG8_WAIT_V(8); PG8_WAIT_L(0); PG8_BAR; PG8_MMA(0, 0, At, B0); PG8_MMA(0, 1, At, B1); PG8_BAR; PG8_SCHED;
            PG8_LDA(At, 0, 1); PG8_STAGE(PG8_SB(0, 0), b2, voffB); PG8_STAGE(PG8_SB(0, 1), b2 + hstepB, voffB); PG8_STAGE(PG8_SA(0, 0), a2, voffA);
            PG8_WAIT_V(8); PG8_WAIT_L(0); PG8_BAR; PG8_MMA(1, 0, At, B0); PG8_MMA(1, 1, At, B1); PG8_BAR; PG8_SCHED;
            PG8_LDB(B0, 1, 0); PG8_LDB(B1, 1, 1); PG8_SCHED; PG8_LDA(At, 1, 0); PG8_STAGE(PG8_SA(0, 1), a2 + hstepA, voffA);
            PG8_WAIT_V(8); PG8_WAIT_L(0); PG8_BAR; PG8_MMA(0, 0, At, B0); PG8_MMA(0, 1, At, B1); PG8_BAR; PG8_SCHED;
            PG8_LDA(At, 1, 1); PG8_STAGE(PG8_SB(1, 0), b3, voffB); PG8_STAGE(PG8_SB(1, 1), b3 + hstepB, voffB); PG8_STAGE(PG8_SA(1, 0), a3, voffA);
            PG8_WAIT_V(8); PG8_WAIT_L(0); PG8_BAR; PG8_MMA(1, 0, At, B0); PG8_MMA(1, 1, At, B1); PG8_BAR; PG8_SCHED;
        }
        if (wr == 0) PG8_BAR;
        E(acc, cur, wr, wc, fr, fq);
        if (!has_next) break;
#pragma unroll
        for (int a = 0; a < 2; ++a)
#pragma unroll
            for (int b = 0; b < 2; ++b)
#pragma unroll
                for (int m = 0; m < 4; ++m)
#pragma unroll
                    for (int n = 0; n < 2; ++n) acc[a][b][m][n] = (f32x4){0.f, 0.f, 0.f, 0.f};
        cur = nxt; cA = nA; cB = nB; ++ui;
        if (wr == 1) PG8_BAR;
    }
    PG8_WAIT_V(0);
    PG8_BAR;
#undef PG8_SA
#undef PG8_SB
#undef PG8_STAGE
#undef PG8_LDA
#undef PG8_LDB
#undef PG8_MMA
#undef PG8_WAIT_V
#undef PG8_WAIT_L
#undef PG8_BAR
#undef PG8_SCHED
}
#define PG8_FOREACH(body) \
    _Pragma("unroll") for (int ai = 0; ai < 2; ++ai) _Pragma("unroll") for (int m = 0; m < 4; ++m) { const int row = u.pm * BM + ai * HALF + wr * 64 + m * 16 + fr; \
    _Pragma("unroll") for (int bj = 0; bj < 2; ++bj) _Pragma("unroll") for (int n = 0; n < 2; ++n) { const int col = u.pn * BM + bj * HALF + wc * 32 + 4 * n + 8 * fq; const f32x4 v = acc[ai][bj][m][n]; body } }

struct EpiProj {
    bf16_t* P; bf16_t* tail;
    DI void operator()(const f32x4 (&acc)[2][2][4][2], const Unit& u, int wr, int wc, int fr, int fq) const {
        PG8_FOREACH({ u32x2 w; w.x = pk2(v[0], v[1]); w.y = pk2(v[2], v[3]); *(u32x2*)(P + (size_t)row * NPROJ + col) = w;
            if (col < 1536 && (row & 63) >= 61) *(u32x2*)(tail + ((size_t)(row >> 6) * 3 + ((row & 63) - 61)) * 1536 + col) = w; })
    }
};
DI int gt_col(int t) { return t < 6 ? 256 * t : (t < 8 ? 2048 + 256 * (t - 6) : 3072 + 256 * (t - 8)); }
struct EpiGate {
    bf16_t* P;
    DI void operator()(const f32x4 (&acc)[2][2][4][2], const Unit& u, int wr, int wc, int fr, int fq) const {
        const int cb = gt_col(u.pn);
#pragma unroll
        for (int ai = 0; ai < 2; ++ai)
#pragma unroll
            for (int m = 0; m < 4; ++m) { const int row = u.pm * BM + ai * HALF + wr * 64 + m * 16 + fr;
#pragma unroll
                for (int bj = 0; bj < 2; ++bj)
#pragma unroll
                    for (int n = 0; n < 2; ++n) { const int col = cb + bj * HALF + wc * 32 + 4 * n + 8 * fq; const f32x4 v = acc[ai][bj][m][n];
                        u32x2 w; w.x = pk2(sigmoid_f(v[0]), sigmoid_f(v[1])); w.y = pk2(sigmoid_f(v[2]), sigmoid_f(v[3])); *(u32x2*)(P + (size_t)row * NPROJ + col) = w; } }
    }
};
struct EpiBranch {
    const bf16_t* GT; bf16_t* Mg;
    DI void operator()(const f32x4 (&acc)[2][2][4][2], const Unit& u, int wr, int wc, int fr, int fq) const {
        const int cb = gt_col(4 * u.r + u.pn); const bool first = (u.r == 0);
#pragma unroll
        for (int ai = 0; ai < 2; ++ai) {
            u32x4 gg[4][2], mm[4][2];
#pragma unroll
            for (int m = 0; m < 4; ++m) { const int row = u.pm * BM + ai * HALF + wr * 64 + m * 16 + fr;
#pragma unroll
                for (int bj = 0; bj < 2; ++bj) { const int co = bj * HALF + wc * 32 + 8 * fq;
                    gg[m][bj] = *(const u32x4*)(GT + (size_t)row * NPROJ + cb + co);
                    mm[m][bj] = first ? (u32x4){0u, 0u, 0u, 0u} : *(const u32x4*)(Mg + (size_t)row * DM + u.pn * BM + co); } }
            __builtin_amdgcn_sched_barrier(0);
#pragma unroll
            for (int m = 0; m < 4; ++m) { const int row = u.pm * BM + ai * HALF + wr * 64 + m * 16 + fr;
#pragma unroll
                for (int bj = 0; bj < 2; ++bj) { const int co = bj * HALF + wc * 32 + 8 * fq; const f32x4 v0 = acc[ai][bj][m][0], v1 = acc[ai][bj][m][1]; const u32x4 g4 = gg[m][bj], m4 = mm[m][bj];
                    u32x4 w; w.x = pk2(bflo(g4.x) * v0[0] + bflo(m4.x), bfhi(g4.x) * v0[1] + bfhi(m4.x)); w.y = pk2(bflo(g4.y) * v0[2] + bflo(m4.y), bfhi(g4.y) * v0[3] + bfhi(m4.y));
                    w.z = pk2(bflo(g4.z) * v1[0] + bflo(m4.z), bfhi(g4.z) * v1[1] + bfhi(m4.z)); w.w = pk2(bflo(g4.w) * v1[2] + bflo(m4.w), bfhi(g4.w) * v1[3] + bfhi(m4.w));
                    *(u32x4*)(Mg + (size_t)row * DM + u.pn * BM + co) = w; } }
        }
    }
};
struct EpiResid {
    const float* xin; float* xout; const float* gate;
    DI void operator()(const f32x4 (&acc)[2][2][4][2], const Unit& u, int wr, int wc, int fr, int fq) const {
        const int b = (u.pm * BM) >> 13; f32x4 gv[2][2];
#pragma unroll
        for (int bj = 0; bj < 2; ++bj)
#pragma unroll
            for (int n = 0; n < 2; ++n) gv[bj][n] = *(const f32x4*)(gate + b * 6144 + u.pn * BM + bj * HALF + wc * 32 + 4 * n + 8 * fq);
#pragma unroll
        for (int aim = 0; aim < 4; ++aim) { const int ai = aim >> 1, m0 = 2 * (aim & 1);
            f32x4 xv[4][2][2];
#pragma unroll
            for (int m = m0; m < m0 + 2; ++m) { const int row = u.pm * BM + ai * HALF + wr * 64 + m * 16 + fr;
#pragma unroll
                for (int bj = 0; bj < 2; ++bj)
#pragma unroll
                    for (int n = 0; n < 2; ++n) xv[m][bj][n] = *(const f32x4*)(xin + (size_t)row * DM + u.pn * BM + bj * HALF + wc * 32 + 4 * n + 8 * fq); }
            __builtin_amdgcn_sched_barrier(0);
#pragma unroll
            for (int m = m0; m < m0 + 2; ++m) { const int row = u.pm * BM + ai * HALF + wr * 64 + m * 16 + fr;
#pragma unroll
                for (int bj = 0; bj < 2; ++bj)
#pragma unroll
                    for (int n = 0; n < 2; ++n) *(f32x4*)(xout + (size_t)row * DM + u.pn * BM + bj * HALF + wc * 32 + 4 * n + 8 * fq) = xv[m][bj][n] + gv[bj][n] * acc[ai][bj][m][n]; }
        }
    }
};
struct EpiUp {
    bf16_t* H;
    DI void operator()(const f32x4 (&acc)[2][2][4][2], const Unit& u, int wr, int wc, int fr, int fq) const {
        PG8_FOREACH({ f32x4 r; for (int e = 0; e < 4; ++e) { const float t = fmaxf(v[e], 0.f); r[e] = t * t; } u32x2 w; w.x = pk2(r[0], r[1]); w.y = pk2(r[2], r[3]); *(u32x2*)(H + (size_t)row * DFF + col) = w; })
    }
};
}

DI void p0_transpose_item(const float* W, int ldw, int col0, int K, bf16_t* WT, int row0, int nblk, LAS float* scr, int item, int lane) {
    const int kb = item / nblk, nb = item % nblk, k0 = 64 * kb, n0 = 32 * nb;
    float tv[32];
#pragma unroll
    for (int i = 0; i < 32; ++i) { const int kk = 2 * i + (lane >> 5); tv[i] = W[(size_t)(k0 + kk) * ldw + col0 + n0 + (lane & 31)]; }
#pragma unroll
    for (int i = 0; i < 32; ++i) { const int kk = 2 * i + (lane >> 5); scr[kk * 33 + (lane & 31)] = tv[i]; }
    asm volatile("s_waitcnt lgkmcnt(0)" ::: "memory");
    const int c = lane & 7;
#pragma unroll
    for (int j = 0; j < 4; ++j) { const int n = (lane >> 3) + 8 * j; const LAS float* s = scr + (8 * c) * 33 + n;
        u32x4 o; o.x = pk2(s[0 * 33], s[1 * 33]); o.y = pk2(s[2 * 33], s[3 * 33]); o.z = pk2(s[4 * 33], s[5 * 33]); o.w = pk2(s[6 * 33], s[7 * 33]);
        *(u32x4*)(WT + (size_t)(row0 + n0 + n) * K + k0 + 8 * c) = o; }
    asm volatile("s_waitcnt lgkmcnt(0)" ::: "memory");
}

DI void convert_weights(const Ctx& F, const Args& a, int l, int gw, int NGW) {
    unsigned char* ws = a.ws;
    LAS float* scr = (LAS float*)(F.lds + 16384 + F.wave * 12288);
    bf16_t* WB = (bf16_t*)(ws + WS_W);
    constexpr int I_IN0 = 16 * 64, I_IN1 = 16 * 48, I_IN2 = 16 * 32, I_G = 16 * 96, I_BR = 8 * 32, I_O = 16 * 32, I_UP = 16 * 128, I_DN = 64 * 32;
    constexpr int I_LAYER = I_IN0 + I_IN1 + I_IN2 + I_G + 3 * I_BR + I_O + I_UP + I_DN;
    bf16_t* wl = WB + (size_t)l * WO_LAYER;
    const float* win = a.in[5] + (size_t)l * DM * DIN;
    for (int it = gw; it < I_LAYER; it += NGW) {
        int r = it;
        if (r < I_IN0) { p0_transpose_item(win, DIN, 0, DM, wl + WO_IN, 0, 64, scr, r, F.lane); continue; } r -= I_IN0;
        if (r < I_IN1) { p0_transpose_item(win, DIN, 2056, DM, wl + WO_IN, 2048, 48, scr, r, F.lane); continue; } r -= I_IN1;
        if (r < I_IN2) { p0_transpose_item(win, DIN, 3600, DM, wl + WO_IN, 3584, 32, scr, r, F.lane); continue; } r -= I_IN2;
        if (r < I_G) { p0_transpose_item(win, DIN, 4624, DM, wl + WO_GATE, 0, 96, scr, r, F.lane); continue; } r -= I_G;
        if (r < 3 * I_BR) { const int rb = r / I_BR; p0_transpose_item(a.in[23] + (size_t)(l * 3 + rb) * 512 * DM, DM, 0, 512, wl + WO_BR + (size_t)rb * DM * 512, 0, 32, scr, r % I_BR, F.lane); continue; } r -= 3 * I_BR;
        if (r < I_O) { p0_transpose_item(a.in[24] + (size_t)l * DM * DM, DM, 0, DM, wl + WO_OUT, 0, 32, scr, r, F.lane); continue; } r -= I_O;
        if (r < I_UP) { p0_transpose_item(a.in[26] + (size_t)l * DM * DFF, DFF, 0, DM, wl + WO_UP, 0, 128, scr, r, F.lane); continue; } r -= I_UP;
        p0_transpose_item(a.in[27] + (size_t)l * DFF * DM, DM, 0, DFF, wl + WO_DOWN, 0, 32, scr, r, F.lane);
    }
}

DI void phase_p0(const Ctx& F, const Args& a) {
    unsigned char* ws = a.ws;
    float* MOD = (float*)(ws + WS_MOD);
    for (int it = F.bid; it < 192; it += F.G) {
        const int l = it / 96, cb = it % 96, col = cb * 64 + F.lane;
        const float* aw = a.in[2] + (size_t)l * DM * 6144; const float* cc = a.in[1];
        float s0 = 0.f, s1 = 0.f, s2 = 0.f, s3 = 0.f;
        for (int k0 = F.wave * 128; k0 < F.wave * 128 + 128; k0 += 16) {
            float wv[16];
#pragma unroll
            for (int j = 0; j < 16; ++j) wv[j] = aw[(size_t)(k0 + j) * 6144 + col];
#pragma unroll
            for (int j = 0; j < 16; ++j) { const int k = k0 + j; s0 += silu_f(cc[k]) * wv[j]; s1 += silu_f(cc[DM + k]) * wv[j]; s2 += silu_f(cc[2 * DM + k]) * wv[j]; s3 += silu_f(cc[3 * DM + k]) * wv[j]; }
        }
        LAS float* red = (LAS float*)F.lds;
        red[(F.wave * 4 + 0) * 64 + F.lane] = s0; red[(F.wave * 4 + 1) * 64 + F.lane] = s1; red[(F.wave * 4 + 2) * 64 + F.lane] = s2; red[(F.wave * 4 + 3) * 64 + F.lane] = s3;
        __syncthreads();
        if (F.tid < 256) { const int b = F.tid >> 6, cl = F.tid & 63; float s = 0.f;
            for (int w = 0; w < 8; ++w) s += red[(w * 4 + b) * 64 + cl];
            MOD[(size_t)(l * 4 + b) * 6144 + cb * 64 + cl] = s + a.in[3][l * 6144 + cb * 64 + cl]; }
        __syncthreads();
    }
    float* WSM = (float*)(ws + WS_WSM);
    for (int e = F.bid * 512 + F.tid; e < 2 * 16 * 1024; e += F.G * 512) {
        const int l = e >> 14, j = (e >> 10) & 15, k = e & 1023; const int col = j < 8 ? 2048 + j : 3592 + (j - 8);
        WSM[e] = a.in[5][((size_t)l * DM + k) * DIN + col];
    }
    convert_weights(F, a, 0, F.bid * 8 + F.wave, F.G * 8);
}
template <bool SMALLC>
DI void phase_norm(const Ctx& F, const float* xsrc, const float* nw, const float* modl  , int sh_off, int sc_off, bf16_t* XN, const float* WSM, float* SMALL) {
    LAS float* wsm = (LAS float*)F.lds;
    if (SMALLC) { for (int e = F.tid; e < 16 * 1024 / 4; e += 512) ((LAS f32x4*)wsm)[e] = ((const f32x4*)WSM)[e]; __syncthreads(); }
    const int gw = F.bid * 8 + F.wave, NGW = F.G * 8, lane = F.lane;
    for (int blk = gw; blk < MTOK / 16; blk += NGW) {
        const int r0 = blk * 16, b = r0 >> 13;
        f32x4 Aj[4], Bj[4];
#pragma unroll
        for (int j = 0; j < 4; ++j) { const int col = 256 * j + 4 * lane; const f32x4 w = *(const f32x4*)(nw + col), sc = *(const f32x4*)(modl + b * 6144 + sc_off + col); Aj[j] = w * (sc + 1.0f); Bj[j] = *(const f32x4*)(modl + b * 6144 + sh_off + col); }
        f32x4 hv[2][4], nx[2][4];
#pragma unroll
        for (int p = 0; p < 2; ++p)
#pragma unroll
            for (int j = 0; j < 4; ++j) { nx[p][j] = __builtin_nontemporal_load((const f32x4*)(xsrc + (size_t)(r0 + p) * DM + 256 * j + 4 * lane)); }
        for (int rr = 0; rr < 16; rr += 2) {
#pragma unroll
            for (int p = 0; p < 2; ++p)
#pragma unroll
                for (int j = 0; j < 4; ++j) hv[p][j] = nx[p][j];
            if (rr + 2 < 16) {
#pragma unroll
                for (int p = 0; p < 2; ++p)
#pragma unroll
                    for (int j = 0; j < 4; ++j) nx[p][j] = __builtin_nontemporal_load((const f32x4*)(xsrc + (size_t)(r0 + rr + 2 + p) * DM + 256 * j + 4 * lane));
            }
            float ss0 = 0.f, ss1 = 0.f;
#pragma unroll
            for (int j = 0; j < 4; ++j) { ss0 += hv[0][j][0] * hv[0][j][0] + hv[0][j][1] * hv[0][j][1] + hv[0][j][2] * hv[0][j][2] + hv[0][j][3] * hv[0][j][3];
                                          ss1 += hv[1][j][0] * hv[1][j][0] + hv[1][j][1] * hv[1][j][1] + hv[1][j][2] * hv[1][j][2] + hv[1][j][3] * hv[1][j][3]; }
#pragma unroll
            for (int o = 1; o < 64; o <<= 1) { ss0 += __shfl_xor(ss0, o); ss1 += __shfl_xor(ss1, o); }
            const float rs0 = rsqrtf(ss0 * (1.f / DM) + 1e-6f), rs1 = rsqrtf(ss1 * (1.f / DM) + 1e-6f);
#pragma unroll
            for (int p = 0; p < 2; ++p) {
                bf16_t* orow = XN + (size_t)(r0 + rr + p) * DM; const float rstd = p == 0 ? rs0 : rs1;
#pragma unroll
                for (int j = 0; j < 4; ++j) { hv[p][j] = hv[p][j] * rstd * Aj[j] + Bj[j]; u32x2 w; w.x = pk2(hv[p][j][0], hv[p][j][1]); w.y = pk2(hv[p][j][2], hv[p][j][3]); *(u32x2*)(orow + 256 * j + 4 * lane) = w; }
            }
            if (SMALLC) {
                float v[32];
#pragma unroll
                for (int c = 0; c < 16; ++c) {
                    asm volatile("" ::: "memory");
                    float a0 = 0.f, a1 = 0.f;
#pragma unroll
                    for (int j = 0; j < 4; ++j) { const f32x4 w = *(const LAS f32x4*)(wsm + c * 1024 + 256 * j + 4 * lane);
                        a0 += hv[0][j][0] * w[0] + hv[0][j][1] * w[1] + hv[0][j][2] * w[2] + hv[0][j][3] * w[3];
                        a1 += hv[1][j][0] * w[0] + hv[1][j][1] * w[1] + hv[1][j][2] * w[2] + hv[1][j][3] * w[3]; }
                    v[c] = a0; v[16 + c] = a1;
                }
#define RS_STEP(N, MASK) do { const bool up_ = (lane & (MASK)) != 0; _Pragma("unroll") for (int k_ = 0; k_ < (N) / 2; ++k_) { const float send_ = up_ ? v[k_] : v[k_ + (N) / 2]; const float keep_ = up_ ? v[k_ + (N) / 2] : v[k_]; v[k_] = keep_ + __shfl_xor(send_, (MASK)); } } while (0)
                RS_STEP(32, 1); RS_STEP(16, 2); RS_STEP(8, 4); RS_STEP(4, 8); RS_STEP(2, 16);
#undef RS_STEP
                const float tot = v[0] + __shfl_xor(v[0], 32);
                if (lane < 32) { const int p = lane & 1, c = 8 * ((lane >> 1) & 1) + 4 * ((lane >> 2) & 1) + 2 * ((lane >> 3) & 1) + ((lane >> 4) & 1); SMALL[(size_t)(r0 + rr + p) * 16 + c] = tot; }
            }
        }
    }
}
DI void phase_final_norm(const Ctx& F, float* x, const float* nw) {
    const int gw = F.bid * 8 + F.wave, NGW = F.G * 8, lane = F.lane;
    for (int r = gw; r < MTOK; r += NGW) {
        float* xr = x + (size_t)r * DM; f32x4 v[4]; float ss = 0.f;
#pragma unroll
        for (int j = 0; j < 4; ++j) { v[j] = __builtin_nontemporal_load((const f32x4*)(xr + 256 * j + 4 * lane)); ss += v[j][0] * v[j][0] + v[j][1] * v[j][1] + v[j][2] * v[j][2] + v[j][3] * v[j][3]; }
        const float rstd = rsqrtf(wave_sum(ss) * (1.f / DM) + 1e-6f);
#pragma unroll
        for (int j = 0; j < 4; ++j) __builtin_nontemporal_store(v[j] * rstd * *(const f32x4*)(nw + 256 * j + 4 * lane), (f32x4*)(xr + 256 * j + 4 * lane));
    }
}

constexpr size_t WS_BAR = 512 * 1024;
#define XB_TMO      128
#define XB_XCNT(j)  (256  + 64 * (j))
#define XB_XSUB(j)  (1280 + 64 * (j))
#define XB_XGEN(j)  (2304 + 64 * (j))
#define XB_TOP      3328
#define XB_TOPGEN   3392
#define XCD_BAR_WORDS 3456
#define XB_SPIN_CAP (1u << 22)
DI unsigned xb_ld(unsigned* p)              { return __hip_atomic_load(p, __ATOMIC_RELAXED, __HIP_MEMORY_SCOPE_AGENT); }
DI unsigned xb_add(unsigned* p, unsigned v) { return __hip_atomic_fetch_add(p, v, __ATOMIC_RELAXED, __HIP_MEMORY_SCOPE_AGENT); }
DI unsigned xb_xcc_id() { return (unsigned)__builtin_amdgcn_s_getreg((3 << 11) | 20) & 0xFu; }
#define XB_SPIN(cond, bar) do { unsigned _sp = 0; while (cond) { __builtin_amdgcn_s_sleep(1); \
    if ((++_sp & 255u) == 0u) { if (xb_ld(&(bar)[XB_TMO])) break; if (_sp > XB_SPIN_CAP) { atomicAdd(&(bar)[XB_TMO], 1u); break; } } } } while (0)
struct XcdBarrier { unsigned* bar; unsigned x; volatile LAS unsigned* st; };
DI XcdBarrier xcd_barrier_post(unsigned* bar, volatile LAS unsigned* st) {
    XcdBarrier b; b.bar = bar; b.x = xb_xcc_id(); b.st = st;
    if (threadIdx.x == 0) (void)xb_add(&bar[XB_XCNT(b.x)], 1u);
    return b;
}
DI void xcd_barrier_complete(unsigned* bar, unsigned x, unsigned& nloc, unsigned& nx) {
    const unsigned G = gridDim.x * gridDim.y * gridDim.z;
    unsigned sum, cnt, mine, sp = 0u;
    for (;;) {
        sum = 0u; cnt = 0u; mine = 0u;
#pragma unroll
        for (unsigned j = 0; j < 16; ++j) { const unsigned c = xb_ld(&bar[XB_XCNT(j)]); sum += c; cnt += (c > 0u) ? 1u : 0u; mine = (j == x) ? c : mine; }
        if (sum == G) break;
        __builtin_amdgcn_s_sleep(1);
        if ((++sp & 255u) == 0u) { if (xb_ld(&bar[XB_TMO])) break; if (sp > XB_SPIN_CAP) { atomicAdd(&bar[XB_TMO], 1u); break; } }
    }
    nloc = mine > 0u ? mine : 1u; nx = cnt > 0u ? cnt : 1u;
}
DI void xcd_barrier(const XcdBarrier& b) {
    asm volatile("s_waitcnt vmcnt(0)" ::: "memory");
    __syncthreads();
    if (threadIdx.x == 0) {
        unsigned* bar = b.bar;
        __builtin_amdgcn_s_waitcnt(0);
        unsigned nloc = b.st[0], nx = b.st[1];
        if (nloc == 0u) { xcd_barrier_complete(bar, b.x, nloc, nx); b.st[0] = nloc; b.st[1] = nx; }
        const unsigned old = xb_add(&bar[XB_XSUB(b.x)], 1u);
        const unsigned gen = old / nloc;
        if (old + 1u == (gen + 1u) * nloc) {
            __builtin_amdgcn_fence(__ATOMIC_RELEASE, "agent");
            asm volatile("s_waitcnt vmcnt(0)" ::: "memory");
            const unsigned og = xb_add(&bar[XB_TOP], 1u);
            const unsigned tg = og / nx;
            if (og + 1u == (tg + 1u) * nx) xb_add(&bar[XB_TOPGEN], 1u);
            else XB_SPIN(xb_ld(&bar[XB_TOPGEN]) == tg, bar);
            __builtin_amdgcn_fence(__ATOMIC_ACQUIRE, "agent");
            xb_add(&bar[XB_XGEN(b.x)], 1u);
            asm volatile("s_waitcnt vmcnt(0)" ::: "memory");
        } else {
            XB_SPIN(xb_ld(&bar[XB_XGEN(b.x)]) == gen, bar);
            __builtin_amdgcn_fence(__ATOMIC_ACQUIRE, "agent");
            asm volatile("s_waitcnt vmcnt(0)" ::: "memory");
        }
    }
    __syncthreads();
}

DI void gdn_prep_unit(const Ctx& F, const Args& a, int l, int unit) {
    const int h = unit & 3, c = (unit >> 2) & 127, b = unit >> 9;
    const int row0 = b * SEQ + c * 64, w = F.wave, lane = F.lane;
    bf16_t* PROJ = (bf16_t*)(a.ws + WS_PROJ);
    const bf16_t* TAIL = (const bf16_t*)(a.ws + WS_TAIL);
    LAS bf16_t* Qs = (LAS bf16_t*)(F.lds);
    LAS bf16_t* Ks = (LAS bf16_t*)(F.lds + 17408);
    LAS bf16_t* KTs = (LAS bf16_t*)(F.lds + 34816);
    LAS bf16_t* VTs = (LAS bf16_t*)(F.lds + 53248);
    LAS float* Ms = (LAS float*)(F.lds + 71680);
    LAS bf16_t* T1s = (LAS bf16_t*)(F.lds + 89088);
    LAS bf16_t* T2s = (LAS bf16_t*)(F.lds + 98304);
    LAS float* beta_s = (LAS float*)(F.lds + 107520);
    LAS float* gcum_s = (LAS float*)(F.lds + 107776);
    if (w < 6) {
        const int part = w % 3, rq = w / 3, r0 = rq * 32;
        const int col = part * 512 + h * 128 + 2 * lane;
        const float* cw = a.in[6] + (size_t)l * 4 * 1536 + col;
        float w0[4], w1[4];
#pragma unroll
        for (int k = 0; k < 4; ++k) { w0[k] = cw[k * 1536]; w1[k] = cw[k * 1536 + 1]; }
        float p0[3], p1[3];
#pragma unroll
        for (int i = 0; i < 3; ++i) {
            unsigned v = 0u;
            if (rq == 0) { if (c > 0) v = *(const unsigned*)(TAIL + ((size_t)(b * 128 + c - 1) * 3 + i) * 1536 + col); }
            else v = *(const unsigned*)(PROJ + (size_t)(row0 + 29 + i) * NPROJ + col);
            p0[i] = bflo(v); p1[i] = bfhi(v);
        }
        float va[32], vb[32];
#pragma unroll
        for (int i = 0; i < 32; ++i) {
            const unsigned v = *(const unsigned*)(PROJ + (size_t)(row0 + r0 + i) * NPROJ + col);
            const float x0 = bflo(v), x1 = bfhi(v);
            const float y0 = w0[0] * p0[0] + w0[1] * p0[1] + w0[2] * p0[2] + w0[3] * x0;
            const float y1 = w1[0] * p1[0] + w1[1] * p1[1] + w1[2] * p1[2] + w1[3] * x1;
            p0[0] = p0[1]; p0[1] = p0[2]; p0[2] = x0; p1[0] = p1[1]; p1[1] = p1[2]; p1[2] = x1;
            va[i] = silu_f(y0); vb[i] = silu_f(y1);
        }
        if (part < 2) {
            const float extra = part == 0 ? 0.08838834764831845f : 1.0f;
            float v[32];
#pragma unroll
            for (int i = 0; i < 32; ++i) v[i] = va[i] * va[i] + vb[i] * vb[i];
#define RS_STEP(N, MASK) do { const bool up_ = (lane & (MASK)) != 0; _Pragma("unroll") for (int k_ = 0; k_ < (N) / 2; ++k_) { const float send_ = up_ ? v[k_] : v[k_ + (N) / 2]; const float keep_ = up_ ? v[k_ + (N) / 2] : v[k_]; v[k_] = keep_ + __shfl_xor(send_, (MASK)); } } while (0)
            RS_STEP(32, 1); RS_STEP(16, 2); RS_STEP(8, 4); RS_STEP(4, 8); RS_STEP(2, 16);
#undef RS_STEP
            const float tot = v[0] + __shfl_xor(v[0], 32);
#pragma unroll
            for (int i = 0; i < 32; ++i) {
                constexpr int dummy = 0; (void)dummy;
                const int src = ((i >> 4) & 1) | (((i >> 3) & 1) << 1) | (((i >> 2) & 1) << 2) | (((i >> 1) & 1) << 3) | ((i & 1) << 4);
                const float ss = __builtin_bit_cast(float, __builtin_amdgcn_readlane(__builtin_bit_cast(int, tot), src));
                const float sc = rsqrtf(ss + 1e-6f) * extra; va[i] *= sc; vb[i] *= sc;
            }
        }
        if (part == 0) {
#pragma unroll
            for (int i = 0; i < 32; ++i) *(LAS unsigned*)(Qs + (r0 + i) * 136 + 2 * lane) = pk2(va[i], vb[i]);
        } else {
            LAS bf16_t* T = part == 1 ? KTs : VTs;
            if (part == 1) {
#pragma unroll
                for (int i = 0; i < 32; ++i) *(LAS unsigned*)(Ks + (r0 + i) * 136 + 2 * lane) = pk2(va[i], vb[i]);
            }
#pragma unroll
            for (int i = 0; i < 32; i += 8) {
                *(LAS u32x4*)(T + (2 * lane) * 72 + r0 + i) = (u32x4){pk2(va[i], va[i + 1]), pk2(va[i + 2], va[i + 3]), pk2(va[i + 4], va[i + 5]), pk2(va[i + 6], va[i + 7])};
                *(LAS u32x4*)(T + (2 * lane + 1) * 72 + r0 + i) = (u32x4){pk2(vb[i], vb[i + 1]), pk2(vb[i + 2], vb[i + 3]), pk2(vb[i + 4], vb[i + 5]), pk2(vb[i + 6], vb[i + 7])}; }
        }
    } else if (w == 6) {
        const float* sm = (const float*)(a.ws + WS_SMALL) + (size_t)(row0 + lane) * 16;
        const float braw = sm[h], araw = sm[4 + h];
        const float g = -__expf(a.in[7][l * 4 + h]) * softplus_f(araw + a.in[8][l * 4 + h]);
        const float gc = wave_incl_scan(g, lane);
        beta_s[lane] = sigmoid_f(braw); gcum_s[lane] = gc;
        ((float*)(a.ws + WS_GC))[((size_t)(b * 4 + h) * 128 + c) * 64 + lane] = __expf(gc);
    }
    GDN_BAR();
    {
        const int mat = w >> 2, ci = w & 3, fr = lane & 15, q = lane >> 4;
        const LAS bf16_t* Xs = mat == 0 ? Ks : Qs;
        const int cc = 16 * ci + fr; const float gcc = gcum_s[cc], bcc = beta_s[cc];
        bf16_t* QKg = (bf16_t*)(a.ws + WS_QK) + (size_t)unit * 4096;
#pragma unroll
        for (int ej = 0; ej < 4; ++ej) {
            f32x4 acc = {0.f, 0.f, 0.f, 0.f};
#pragma unroll
            for (int s = 0; s < 4; ++s) acc = MFMA16(ldfrag(Ks, 136, 16 * ej + fr, 32 * s + 8 * q), ldfrag(Xs, 136, cc, 32 * s + 8 * q), acc);
            const int e0 = 16 * ej + 4 * q; f32x4 o;
#pragma unroll
            for (int r = 0; r < 4; ++r) { const int e = e0 + r; const float dec = __expf(gcc - gcum_s[e]);
                if (mat == 0) o[r] = (e < cc) ? bcc * acc[r] * dec : 0.f; else o[r] = (e <= cc) ? acc[r] * dec : 0.f; }
            if (mat == 0) *(LAS f32x4*)(Ms + cc * 68 + e0) = o;
            else { u32x2 wv; wv.x = pk2(o[0], o[1]); wv.y = pk2(o[2], o[3]); *(u32x2*)(QKg + cc * 64 + 16 * ej + 4 * (((q & 1) << 1) | (q >> 1))) = wv; }
        }
    }
    GDN_BAR();
    if (w == 0) {
        float t[64]; const float flane = (float)lane;
        LAS unsigned char* msb = (LAS unsigned char*)Ms; asm volatile("" : "+v"(msb));
        f32x4 mc[16], mn[16];
#pragma unroll
        for (int v = 0; v < 16; ++v) { mc[v] = (f32x4){0.f, 0.f, 0.f, 0.f}; mn[v] = mc[v]; }
        t[0] = fmaxf(0.f, 1.f - fabsf(flane));
        mc[0] = *(const LAS f32x4*)(msb + (1 * 68) * 4);
#pragma clang loop unroll(full)
        for (int i = 1; i < 64; ++i) {
            if (i + 1 < 64) {
#pragma unroll
                for (int v = 0; v < 16; ++v) if (4 * v < i + 1) mn[v] = *(const LAS f32x4*)(msb + ((i + 1) * 68 + 4 * v) * 4);
            }
            __builtin_amdgcn_sched_barrier(0);
            float s0 = fmaxf(0.f, 1.f - fabsf(flane - (float)i)), s1 = 0.f, s2 = 0.f, s3 = 0.f;
#pragma unroll
            for (int v = 0; v < 16; ++v) {
                if (4 * v < i) s0 -= mc[v][0] * t[4 * v];
                if (4 * v + 1 < i) s1 -= mc[v][1] * t[4 * v + 1];
                if (4 * v + 2 < i) s2 -= mc[v][2] * t[4 * v + 2];
                if (4 * v + 3 < i) s3 -= mc[v][3] * t[4 * v + 3];
            }
            t[i] = (s0 + s1) + (s2 + s3);
#pragma unroll
            for (int v = 0; v < 16; ++v) mc[v] = mn[v];
            __builtin_amdgcn_sched_barrier(0);
        }
        const float b1 = beta_s[lane], b2 = b1 * __expf(gcum_s[lane]);
#pragma unroll
        for (int i = 0; i < 64; ++i) { T1s[i * 72 + lane] = (bf16_t)f2bf(t[i] * b1); T2s[i * 72 + lane] = (bf16_t)f2bf(t[i] * b2); }
    } else {
        const int t = F.tid - 64; const float glast = gcum_s[63];
        bf16_t* KDTg = (bf16_t*)(a.ws + WS_KDT) + (size_t)unit * 8192;
        for (int v = t; v < 1024; v += 448) {
            const int dk = v >> 3, c8 = (v & 7) * 8;
            const u32x4 kv = *(const LAS u32x4*)(KTs + dk * 72 + c8); float sc[8];
#pragma unroll
            for (int j = 0; j < 8; ++j) sc[j] = __expf(glast - gcum_s[c8 + j]);
            u32x4 o; o.x = pk2(bflo(kv.x) * sc[0], bfhi(kv.x) * sc[1]); o.y = pk2(bflo(kv.y) * sc[2], bfhi(kv.y) * sc[3]); o.z = pk2(bflo(kv.z) * sc[4], bfhi(kv.z) * sc[5]); o.w = pk2(bflo(kv.w) * sc[6], bfhi(kv.w) * sc[7]);
            { const int b16 = c8 & ~15, hf = (c8 >> 3) & 1; *(u32x2*)(KDTg + dk * 64 + b16 + 4 * hf) = (u32x2){o.x, o.y}; *(u32x2*)(KDTg + dk * 64 + b16 + 8 + 4 * hf) = (u32x2){o.z, o.w}; }
        }
        for (int v = t; v < 1024; v += 448) {
            const int row = v >> 4, k8 = (v & 15) * 8;
            { const u32x4 qv = *(const LAS u32x4*)(Qs + row * 136 + k8); const int b16 = k8 & ~15, hf = (k8 >> 3) & 1; bf16_t* qp = PROJ + (size_t)(row0 + row) * NPROJ + PC_Q + h * 128 + b16;
              *(u32x2*)(qp + 4 * hf) = (u32x2){qv.x, qv.y}; *(u32x2*)(qp + 8 + 4 * hf) = (u32x2){qv.z, qv.w}; }
        }
    }
    GDN_BAR();
    {
        const int fr = lane & 15, q = lane >> 4;
#pragma unroll
        for (int ci = 0; ci < 4; ++ci) {
            f32x4 acc = {0.f, 0.f, 0.f, 0.f};
#pragma unroll
            for (int s = 0; s < 2; ++s) acc = MFMA16(ldfrag(KTs, 72, 16 * w + fr, 32 * s + 8 * q), ldfrag(T2s, 72, 16 * ci + fr, 32 * s + 8 * q), acc);
            u32x2 wv; wv.x = pk2(acc[0], acc[1]); wv.y = pk2(acc[2], acc[3]);
            *(u32x2*)(PROJ + (size_t)(row0 + 16 * ci + fr) * NPROJ + PC_K + h * 128 + 16 * w + 4 * (((q & 1) << 1) | (q >> 1))) = wv;
            f32x4 au = {0.f, 0.f, 0.f, 0.f};
#pragma unroll
            for (int s = 0; s < 2; ++s) au = MFMA16(ldfrag(T1s, 72, 16 * ci + fr, 32 * s + 8 * q), ldfrag(VTs, 72, 16 * w + fr, 32 * s + 8 * q), au);
            const int L = (w >> 1) * 64 + (q & 1) * 32 + 16 * (w & 1) + fr, pos = (ci >> 1) * 16 + 4 * (2 * (ci & 1) + (q >> 1));
            u32x2 uv; uv.x = pk2(au[0], au[1]); uv.y = pk2(au[2], au[3]);
            *(u32x2*)(PROJ + (size_t)(row0 + (L >> 2)) * NPROJ + PC_V + h * 128 + (L & 3) * 32 + pos) = uv;
        }
    }
    GDN_BAR();
}

DI void gdn_cons_iter(LAS unsigned char* lds, int c, int climit, f32x16 (&S)[4], u32x4 (&UC)[4], const bf16_t* urec, int n, int hh, int dv0) {
    constexpr int BUFB = 62464, OFF_Q = 17408, OFF_QK = 34816, OFF_KD = 44032, OFF_GC = 2 * BUFB, OFF_OS = OFF_GC + 512;
    const LAS bf16_t* Wl = (const LAS bf16_t*)(lds + (c & 1) * BUFB);
    const LAS bf16_t* Ql = (const LAS bf16_t*)(lds + (c & 1) * BUFB + OFF_Q);
    const LAS bf16_t* QKl = (const LAS bf16_t*)(lds + (c & 1) * BUFB + OFF_QK);
    const LAS bf16_t* KDl = (const LAS bf16_t*)(lds + (c & 1) * BUFB + OFF_KD);
    const LAS float* gc = (const LAS float*)(lds + OFF_GC) + (c & 1) * 64;
    LAS bf16_t* Og = (LAS bf16_t*)(lds + OFF_OS) + (c & 1) * (64 * 136) + dv0 + n;
    bf16x8 f0[4], f1[4], f2[4];
#define LD4(dst, base, pitch, row, kofs) do { _Pragma("unroll") for (int k_ = 0; k_ < 4; ++k_) dst[k_] = ldfrag(base, pitch, (row), (kofs) + 16 * k_ + 8 * hh); } while (0)
#define MM4(acc, fr, bb, bo) do { _Pragma("unroll") for (int k_ = 0; k_ < 4; ++k_) acc = MFMA32(fr[k_], bb[(bo) + k_], acc); } while (0)
    LD4(f0, Wl, 136, n, 0); LD4(f1, Wl, 136, n, 64); LD4(f2, Wl, 136, 32 + n, 0);
    bf16x8 Sb[8];
#pragma unroll
    for (int k = 0; k < 8; ++k) { const int t = k >> 1, s8 = 8 * (k & 1); Sb[k] = pack8(S[t][s8], S[t][s8 + 1], S[t][s8 + 2], S[t][s8 + 3], S[t][s8 + 4], S[t][s8 + 5], S[t][s8 + 6], S[t][s8 + 7]); }
    const float gt = gc[63];
    SCHEDB();
    f32x16 WS0, WS1;
#pragma unroll
    for (int r = 0; r < 16; ++r) { WS0[r] = 0.f; WS1[r] = 0.f; }
    MM4(WS0, f0, Sb, 0); SCHEDB(); LD4(f0, Wl, 136, 32 + n, 64); SCHEDB();
    MM4(WS0, f1, Sb, 4); SCHEDB(); LD4(f1, Ql, 136, n, 0); SCHEDB();
    MM4(WS1, f2, Sb, 0); SCHEDB(); LD4(f2, Ql, 136, n, 64); SCHEDB();
    MM4(WS1, f0, Sb, 4); SCHEDB();
    f0[0] = ldfrag(QKl, 72, n, 8 * hh); f0[1] = ldfrag(QKl, 72, n, 16 + 8 * hh); SCHEDB();
    bf16x8 Vb[4];
    {
        float vn[16];
#pragma unroll
        for (int r = 0; r < 16; ++r) { const unsigned uw = UC[r >> 3][(r >> 1) & 3]; vn[r] = ((r & 1) ? bfhi(uw) : bflo(uw)) - WS0[r]; }
        Vb[0] = pack8(vn[0], vn[1], vn[2], vn[3], vn[4], vn[5], vn[6], vn[7]); Vb[1] = pack8(vn[8], vn[9], vn[10], vn[11], vn[12], vn[13], vn[14], vn[15]);
#pragma unroll
        for (int r = 0; r < 16; ++r) { const unsigned uw = UC[2 + (r >> 3)][(r >> 1) & 3]; vn[r] = ((r & 1) ? bfhi(uw) : bflo(uw)) - WS1[r]; }
        Vb[2] = pack8(vn[0], vn[1], vn[2], vn[3], vn[4], vn[5], vn[6], vn[7]); Vb[3] = pack8(vn[8], vn[9], vn[10], vn[11], vn[12], vn[13], vn[14], vn[15]);
    }
    if (c + 1 < climit) { const bf16_t* un = urec + (size_t)(c + 1) * 64 * NPROJ;
#pragma unroll
        for (int j = 0; j < 4; ++j) UC[j] = *(const u32x4*)(un + 8 * j); }
    SCHEDB();
    {
        f32x16 O;
#pragma unroll
        for (int r = 0; r < 16; ++r) O[r] = 0.f;
        MM4(O, f1, Sb, 0); SCHEDB(); LD4(f1, Ql, 136, 32 + n, 0); SCHEDB();
        MM4(O, f2, Sb, 4); SCHEDB(); LD4(f2, Ql, 136, 32 + n, 64); SCHEDB();
#pragma unroll
        for (int r = 0; r < 16; ++r) O[r] *= gc[crow(r, hh)];
        O = MFMA32(f0[0], Vb[0], O); O = MFMA32(f0[1], Vb[1], O);
        SCHEDB(); LD4(f0, QKl, 72, 32 + n, 0); SCHEDB();
#pragma unroll
        for (int r = 0; r < 16; ++r) Og[crow(r, hh) * 136] = (bf16_t)f2bf(O[r]);
    }
    SCHEDB();
    {
        f32x16 O;
#pragma unroll
        for (int r = 0; r < 16; ++r) O[r] = 0.f;
        MM4(O, f1, Sb, 0); SCHEDB(); LD4(f1, KDl, 72, n, 0); SCHEDB();
        MM4(O, f2, Sb, 4); SCHEDB(); LD4(f2, KDl, 72, 32 + n, 0); SCHEDB();
#pragma unroll
        for (int r = 0; r < 16; ++r) O[r] *= gc[32 + crow(r, hh)];
        MM4(O, f0, Vb, 0); SCHEDB(); LD4(f0, KDl, 72, 64 + n, 0); SCHEDB();
#pragma unroll
        for (int r = 0; r < 16; ++r) Og[(32 + crow(r, hh)) * 136] = (bf16_t)f2bf(O[r]);
    }
    SCHEDB();
#pragma unroll
    for (int t = 0; t < 4; ++t)
#pragma unroll
        for (int r = 0; r < 16; ++r) S[t][r] *= gt;
    MM4(S[0], f1, Vb, 0); SCHEDB(); LD4(f1, KDl, 72, 96 + n, 0); SCHEDB();
    MM4(S[1], f2, Vb, 0); SCHEDB();
    MM4(S[2], f0, Vb, 0); SCHEDB();
    MM4(S[3], f1, Vb, 0);
    GDN_BAR();
#undef MM4
#undef LD4
}
DI void gdn_seq(const Ctx& F, const Args& a, int l, int bh, const XcdBarrier& xbar) {
    const int b = bh >> 2, h = bh & 3, w = F.wave, lane = F.lane, n = lane & 31, hh = lane >> 5;
    bf16_t* PROJ = (bf16_t*)(a.ws + WS_PROJ);
    const bf16_t* QKa = (const bf16_t*)(a.ws + WS_QK);
    const bf16_t* KDTa = (const bf16_t*)(a.ws + WS_KDT);
    const float* GC = (const float*)(a.ws + WS_GC) + (size_t)bh * 128 * 64;
    constexpr int BUFB = 62464, OFF_Q = 17408, OFF_QK = 34816, OFF_KD = 44032, OFF_GC = 2 * BUFB, OFF_OS = OFF_GC + 512;
    LAS float* gcs = (LAS float*)(F.lds + OFF_GC);
    LAS float* Os = (LAS float*)(F.lds + OFF_OS);
    const int rowb = b * SEQ;
    if (w < 4) {
        const int dv0 = 32 * w;
        f32x16 S[4];
#pragma unroll
        for (int t = 0; t < 4; ++t)
#pragma unroll
            for (int i = 0; i < 16; ++i) S[t][i] = 0.f;
        const int L = w * 64 + lane;
        const bf16_t* urec = PROJ + (size_t)(rowb + (L >> 2)) * NPROJ + PC_V + h * 128 + (L & 3) * 32;
        u32x4 uA[4];
        for (int half = 0; half < 2; ++half) {
            const int c0 = 64 * half;
            if (half == 1) xcd_barrier(xbar);
#pragma unroll
            for (int j = 0; j < 4; ++j) uA[j] = *(const u32x4*)(urec + (size_t)c0 * 64 * NPROJ + 8 * j);
            GDN_BAR();
            for (int c = c0; c < c0 + 64; ++c) gdn_cons_iter(F.lds, c, c0 + 64, S, uA, urec, n, hh, dv0);
            GDN_BAR();
        }
    } else {
        const int lt = F.tid - 256, nrow = lt >> 2, nseg = lt & 3;
        u32x4 preA[14]; f32x4 pgA = {0.f, 0.f, 0.f, 0.f};
        const unsigned offWQ = (unsigned)(((lt >> 4) * NPROJ + (lt & 15) * 8) * 2), offLin = (unsigned)(lt * 16), offZ = (unsigned)((nrow * NPROJ + nseg * 32) * 2);
#define GDN_LDG(base, off) (*(const u32x4*)((const char*)(base) + (off)))
#define GDN_ISSUE(pre, pg, cc) do { const bf16_t* wb_ = PROJ + (size_t)(rowb + (cc) * 64) * NPROJ + PC_K + h * 128; const bf16_t* qb_ = PROJ + (size_t)(rowb + (cc) * 64) * NPROJ + PC_Q + h * 128; \
            const bf16_t* kd_ = KDTa + (size_t)((b * 128 + (cc)) * 4 + h) * 8192; const bf16_t* qk_ = QKa + (size_t)((b * 128 + (cc)) * 4 + h) * 4096; \
            _Pragma("unroll") for (int j = 0; j < 4; ++j) { pre[j] = GDN_LDG(wb_, offWQ + (unsigned)(16 * j * NPROJ * 2)); pre[4 + j] = GDN_LDG(qb_, offWQ + (unsigned)(16 * j * NPROJ * 2)); pre[10 + j] = GDN_LDG(kd_, offLin + 4096u * j); } \
            _Pragma("unroll") for (int j = 0; j < 2; ++j) pre[8 + j] = GDN_LDG(qk_, offLin + 4096u * j); \
            if (lt < 16) pg = *(const f32x4*)(GC + (cc) * 64 + lt * 4); } while (0)
#define GDN_WRITE(pre, pg, cc) do { LAS unsigned char* bb = F.lds + ((cc) & 1) * BUFB; \
            _Pragma("unroll") for (int j = 0; j < 4; ++j) { const int id = lt + 256 * j; *(LAS u32x4*)(bb + (id >> 4) * 272 + (id & 15) * 16) = pre[j]; \
                *(LAS u32x4*)(bb + OFF_Q + (id >> 4) * 272 + (id & 15) * 16) = pre[4 + j]; \
                *(LAS u32x4*)(bb + OFF_KD + (id >> 3) * 144 + (id & 7) * 16) = pre[10 + j]; } \
            _Pragma("unroll") for (int j = 0; j < 2; ++j) { const int id = lt + 256 * j; *(LAS u32x4*)(bb + OFF_QK + (id >> 3) * 144 + (id & 7) * 16) = pre[8 + j]; } \
            if (lt < 16) *(LAS f32x4*)(gcs + ((cc) & 1) * 64 + lt * 4) = pg; } while (0)
        for (int half = 0; half < 2; ++half) {
        const int c0 = 64 * half, c1 = c0 + 64;
        if (half == 1) xcd_barrier(xbar);
        GDN_ISSUE(preA, pgA, c0); GDN_WRITE(preA, pgA, c0); GDN_ISSUE(preA, pgA, c0 + 1);
        GDN_BAR();
#define GDN_COPY_O(cc) do { const LAS unsigned char* os_ = F.lds + OFF_OS + ((cc) & 1) * (64 * 136 * 2) + nrow * 272 + nseg * 64; \
            bf16_t* og_ = (bf16_t*)(a.ws + WS_KDT) + (size_t)((b * 128 + (cc)) * 4 + h) * 8192 + nrow * 128 + nseg * 32; \
            _Pragma("unroll") for (int j = 0; j < 4; ++j) *(u32x4*)(og_ + 8 * j) = *(const LAS u32x4*)(os_ + 16 * j); } while (0)
        for (int c = c0; c < c1; ++c) {
            if (c + 1 < c1) { GDN_WRITE(preA, pgA, c + 1); if (c + 2 < c1) GDN_ISSUE(preA, pgA, c + 2); }
            if (c > c0) GDN_COPY_O(c - 1);
            GDN_BAR();
        }
        GDN_COPY_O(c1 - 1);
        GDN_BAR();
        }
#undef GDN_COPY_O
#undef GDN_ISSUE
#undef GDN_WRITE
#undef GDN_READ_OS
#undef GDN_NORM_STORE
    }
}

DI void gdn_post(const Ctx& F, const Args& a, int l) {
    bf16_t* PROJ = (bf16_t*)(a.ws + WS_PROJ);
    const bf16_t* OG = (const bf16_t*)(a.ws + WS_KDT);
    const int sub = F.lane >> 4, l16 = F.lane & 15;
    const float* nwp = a.in[9] + l * 128 + l16 * 8;
    float nw[8];
#pragma unroll
    for (int j = 0; j < 8; ++j) nw[j] = nwp[j];
    for (int it = (F.bid * 8 + F.wave) * 4 + sub; it < MTOK * 4; it += F.G * 32) {
        const int row = it >> 2, h = it & 3, b = row >> 13, c = (row >> 6) & 127, rr = row & 63;
        const u32x4 ov = __builtin_nontemporal_load((const u32x4*)(OG + (size_t)((b * 128 + c) * 4 + h) * 8192 + rr * 128 + l16 * 8));
        bf16_t* zp = PROJ + (size_t)row * NPROJ + PC_GZ + h * 128 + l16 * 8;
        const u32x4 zv = __builtin_nontemporal_load((const u32x4*)zp);
        const unsigned oo[4] = {ov.x, ov.y, ov.z, ov.w}, zz[4] = {zv.x, zv.y, zv.z, zv.w};
        float ss = 0.f;
#pragma unroll
        for (int e = 0; e < 4; ++e) { const float a0 = bflo(oo[e]), a1 = bfhi(oo[e]); ss += a0 * a0 + a1 * a1; }
        ss += __shfl_xor(ss, 1); ss += __shfl_xor(ss, 2); ss += __shfl_xor(ss, 4); ss += __shfl_xor(ss, 8);
        const float rstd = rsqrtf(ss * (1.f / 128.f) + 1e-6f);
        unsigned yy[4];
#pragma unroll
        for (int e = 0; e < 4; ++e) yy[e] = pk2(bflo(oo[e]) * rstd * nw[2 * e] * silu_f(bflo(zz[e])), bfhi(oo[e]) * rstd * nw[2 * e + 1] * silu_f(bfhi(zz[e])));
        *(u32x4*)zp = (u32x4){yy[0], yy[1], yy[2], yy[3]};
    }
}

DI void ssd_pass_a(const Ctx& F, const Args& a, int l, int unit) {
    const int h = unit & 7, seg = (unit >> 3) & 15, b = unit >> 7, g = h >> 2;
    const int w = F.wave, lane = F.lane, tid = F.tid, fr = lane & 15, q = lane >> 4;
    const bf16_t* PROJ = (const bf16_t*)(a.ws + WS_PROJ);
    LAS bf16_t* XTs = (LAS bf16_t*)F.lds;
    LAS bf16_t* BTs = (LAS bf16_t*)(F.lds + 9216);
    LAS float* dt_s = (LAS float*)(F.lds + 27648);
    LAS float* ac_s = (LAS float*)(F.lds + 27904);
    f32x4 ST[4];
#pragma unroll
    for (int j = 0; j < 4; ++j) ST[j] = (f32x4){0.f, 0.f, 0.f, 0.f};
    const bool cact = tid < 384; const int cp = tid % 96, kq = tid / 96, col2 = 2 * cp; const bool isx = col2 < 64;
    const int pcol = isx ? PC_SX + h * 64 + col2 : PC_BM + g * 128 + (col2 - 64);
    const int cch = isx ? h * 64 + col2 : 512 + g * 128 + (col2 - 64);
    float cw0[4], cw1[4];
#pragma unroll
    for (int k = 0; k < 4; ++k) { cw0[k] = a.in[10][(size_t)(l * 4 + k) * 1024 + cch]; cw1[k] = a.in[10][(size_t)(l * 4 + k) * 1024 + cch + 1]; }
    const float cb0 = a.in[11][l * 1024 + cch], cb1 = a.in[11][l * 1024 + cch + 1];
    const int rseg = b * SEQ + seg * 512;
    const float dtb = a.in[13][l * 8 + h], negA = -__expf(a.in[12][l * 8 + h]);
    float ltot = 0.f;
    unsigned raw[19], rawn[19]; float dtr = 0.f, dtrn = 0.f;
#pragma unroll
    for (int i = 0; i < 19; ++i) { rawn[i] = 0u; if (cact) { const int lr = 16 * kq - 3 + i; rawn[i] = (seg == 0 && lr < 0) ? 0u : *(const unsigned*)(PROJ + (size_t)(rseg + lr) * NPROJ + pcol); } }
    if (w == 7) dtrn = ((const float*)(a.ws + WS_SMALL))[(size_t)(rseg + lane) * 16 + 8 + h];
    for (int ch = 0; ch < 8; ++ch) {
        const int rowc = rseg + ch * 64;
#pragma unroll
        for (int i = 0; i < 19; ++i) raw[i] = rawn[i];
        dtr = dtrn;
        if (ch + 1 < 8) {
            if (cact) {
#pragma unroll
                for (int i = 0; i < 19; ++i) rawn[i] = *(const unsigned*)(PROJ + (size_t)(rowc + 64 + 16 * kq - 3 + i) * NPROJ + pcol);
            }
            if (w == 7) dtrn = ((const float*)(a.ws + WS_SMALL))[(size_t)(rowc + 64 + lane) * 16 + 8 + h];
        }
        if (w == 7) {
            const float dtv = softplus_f(dtr + dtb);
            const float ac = wave_incl_scan(dtv * negA, lane);
            dt_s[lane] = dtv; ac_s[lane] = ac;
        }
        GDN_BAR();
        if (cact) {
            const float al = ac_s[63];
            float y0[16], y1[16];
#pragma unroll
            for (int i = 0; i < 16; ++i) {
                float a0 = cw0[0] * bflo(raw[i]) + cw0[1] * bflo(raw[i + 1]) + cw0[2] * bflo(raw[i + 2]) + cw0[3] * bflo(raw[i + 3]) + cb0;
                float a1 = cw1[0] * bfhi(raw[i]) + cw1[1] * bfhi(raw[i + 1]) + cw1[2] * bfhi(raw[i + 2]) + cw1[3] * bfhi(raw[i + 3]) + cb1;
                a0 = silu_f(a0); a1 = silu_f(a1);
                if (isx) { const int r = 16 * kq + i; const float sc = dt_s[r] * __expf(al - ac_s[r]); a0 *= sc; a1 *= sc; }
                y0[i] = a0; y1[i] = a1;
            }
            LAS bf16_t* T = isx ? XTs + col2 * 72 : BTs + (col2 - 64) * 72;
#pragma unroll
            for (int i = 0; i < 16; i += 8) {
                *(LAS u32x4*)(T + 16 * kq + i) = (u32x4){pk2(y0[i], y0[i + 1]), pk2(y0[i + 2], y0[i + 3]), pk2(y0[i + 4], y0[i + 5]), pk2(y0[i + 6], y0[i + 7])};
                *(LAS u32x4*)(T + 72 + 16 * kq + i) = (u32x4){pk2(y1[i], y1[i + 1]), pk2(y1[i + 2], y1[i + 3]), pk2(y1[i + 4], y1[i + 5]), pk2(y1[i + 6], y1[i + 7])}; }
        }
        GDN_BAR();
        {
            const float dc = __expf(ac_s[63]);
            ltot += ac_s[63];
#pragma unroll
            for (int pj = 0; pj < 4; ++pj) {
                ST[pj] = ST[pj] * dc;
#pragma unroll
                for (int s2 = 0; s2 < 2; ++s2) ST[pj] = MFMA16(ldfrag(BTs, 72, 16 * w + fr, 32 * s2 + 8 * q), ldfrag(XTs, 72, 16 * pj + fr, 32 * s2 + 8 * q), ST[pj]);
            }
        }
        GDN_BAR();
    }
    float* SS = (float*)(a.ws + WS_SSEG) + (size_t)unit * 8192;
#pragma unroll
    for (int pj = 0; pj < 4; ++pj)
#pragma unroll
        for (int r = 0; r < 4; ++r) SS[(16 * w + 4 * q + r) * 64 + 16 * pj + fr] = ST[pj][r];
    if (tid == 0) ((float*)(a.ws + WS_LSEG))[unit] = ltot;
}

DI void ssd_pass_c(const Ctx& F, const Args& a, int l, int unit) {
    const int seg = unit & 15, g = (unit >> 4) & 1, b = unit >> 5;
    const int w = F.wave, lane = F.lane, tid = F.tid, fr = lane & 15, q = lane >> 4, hd = w >> 1, e2 = w & 1, head = g * 4 + hd;
    bf16_t* PROJ = (bf16_t*)(a.ws + WS_PROJ);
    LAS bf16_t* Cs = (LAS bf16_t*)F.lds;
    LAS bf16_t* Bs = (LAS bf16_t*)(F.lds + 17408);
    LAS bf16_t* BTs = (LAS bf16_t*)(F.lds + 34816);
    LAS bf16_t* XTs = (LAS bf16_t*)(F.lds + 53248);
    LAS float* CBs = (LAS float*)(F.lds + 90112);
    LAS float* dt_s = (LAS float*)(F.lds + 107520);
    LAS float* ac_s = (LAS float*)(F.lds + 108544);
    LAS float* rss = (LAS float*)(F.lds + 109568);
    f32x4 ST[8][2];
#pragma unroll
    for (int si = 0; si < 8; ++si)
#pragma unroll
        for (int pl = 0; pl < 2; ++pl) ST[si][pl] = (f32x4){0.f, 0.f, 0.f, 0.f};
    for (int j = 0; j < seg; ++j) {
        const int ua = (b * 16 + j) * 8 + head;
        const float dcj = __expf(((const float*)(a.ws + WS_LSEG))[ua]);
        const float* SS = (const float*)(a.ws + WS_SSEG) + (size_t)ua * 8192;
#pragma unroll
        for (int si = 0; si < 8; ++si)
#pragma unroll
            for (int pl = 0; pl < 2; ++pl)
#pragma unroll
                for (int r = 0; r < 4; ++r) ST[si][pl][r] = ST[si][pl][r] * dcj + SS[(16 * si + 4 * q + r) * 64 + 16 * (2 * e2 + pl) + fr];
    }
    const int cp = tid & 255, kq = tid >> 8, col2 = 2 * cp; const int ctype = col2 < 256 ? 0 : (col2 < 384 ? 1 : 2);
    const int pcol = ctype == 0 ? PC_SX + g * 256 + col2 : (ctype == 1 ? PC_BM + g * 128 + (col2 - 256) : PC_CM + g * 128 + (col2 - 384));
    const int cch = ctype == 0 ? g * 256 + col2 : (ctype == 1 ? 512 + g * 128 + (col2 - 256) : 768 + g * 128 + (col2 - 384));
    float cw0[4], cw1[4];
#pragma unroll
    for (int k = 0; k < 4; ++k) { cw0[k] = a.in[10][(size_t)(l * 4 + k) * 1024 + cch]; cw1[k] = a.in[10][(size_t)(l * 4 + k) * 1024 + cch + 1]; }
    const float cb0 = a.in[11][l * 1024 + cch], cb1 = a.in[11][l * 1024 + cch + 1];
    const int rseg = b * SEQ + seg * 512;
    const float dskip = a.in[14][l * 8 + head];
    float nwv[2]; nwv[0] = a.in[15][l * 512 + g * 256 + hd * 64 + 16 * (2 * e2) + fr]; nwv[1] = a.in[15][l * 512 + g * 256 + hd * 64 + 16 * (2 * e2 + 1) + fr];
    for (int ch = 0; ch < 8; ++ch) {
        const int rowc = rseg + ch * 64;
        if (w < 4) {
            const int hw = g * 4 + w;
            const float dtv = softplus_f(((const float*)(a.ws + WS_SMALL))[(size_t)(rowc + lane) * 16 + 8 + hw] + a.in[13][l * 8 + hw]);
            const float ac = wave_incl_scan(dtv * (-__expf(a.in[12][l * 8 + hw])), lane);
            dt_s[w * 64 + lane] = dtv; ac_s[w * 64 + lane] = ac;
        }
        {
            unsigned raw[35];
#pragma unroll
            for (int i = 0; i < 35; ++i) { const int lr = 32 * kq - 3 + i; raw[i] = (seg == 0 && ch == 0 && lr < 0) ? 0u : *(const unsigned*)(PROJ + (size_t)(rowc + lr) * NPROJ + pcol); }
            float yp0 = 0.f, yp1 = 0.f; unsigned t0[16], t1[16];
#pragma unroll
            for (int i = 0; i < 32; ++i) {
                float a0 = cw0[0] * bflo(raw[i]) + cw0[1] * bflo(raw[i + 1]) + cw0[2] * bflo(raw[i + 2]) + cw0[3] * bflo(raw[i + 3]) + cb0;
                float a1 = cw1[0] * bfhi(raw[i]) + cw1[1] * bfhi(raw[i + 1]) + cw1[2] * bfhi(raw[i + 2]) + cw1[3] * bfhi(raw[i + 3]) + cb1;
                a0 = silu_f(a0); a1 = silu_f(a1);
                const int r = 32 * kq + i;
                if (ctype == 1) *(LAS unsigned*)(Bs + r * 136 + (col2 - 256)) = pk2(a0, a1);
                if (ctype == 2) *(LAS unsigned*)(Cs + r * 136 + (col2 - 384)) = pk2(a0, a1);
                if (i & 1) { t0[i >> 1] = pk2(yp0, a0); t1[i >> 1] = pk2(yp1, a1); }
                yp0 = a0; yp1 = a1;
            }
            if (ctype < 2) { LAS bf16_t* T = ctype == 0 ? XTs + col2 * 72 : BTs + (col2 - 256) * 72;
#pragma unroll
                for (int v = 0; v < 4; ++v) { *(LAS u32x4*)(T + 32 * kq + 8 * v) = (u32x4){t0[4 * v], t0[4 * v + 1], t0[4 * v + 2], t0[4 * v + 3]}; *(LAS u32x4*)(T + 72 + 32 * kq + 8 * v) = (u32x4){t1[4 * v], t1[4 * v + 1], t1[4 * v + 2], t1[4 * v + 3]}; } }
        }
        GDN_BAR();
        {
            const int ci = w >> 1;
#pragma unroll
            for (int ee = 0; ee < 2; ++ee) {
                const int ej = 2 * (w & 1) + ee; f32x4 acc = {0.f, 0.f, 0.f, 0.f};
#pragma unroll
                for (int s = 0; s < 4; ++s) acc = MFMA16(ldfrag(Bs, 136, 16 * ej + fr, 32 * s + 8 * q), ldfrag(Cs, 136, 16 * ci + fr, 32 * s + 8 * q), acc);
                *(LAS f32x4*)(CBs + (16 * ci + fr) * 68 + 16 * ej + 4 * q) = acc;
            }
        }
        f32x4 Y[4][2];
        {
            bf16x8 STb[2][4];
#pragma unroll
            for (int pl = 0; pl < 2; ++pl)
#pragma unroll
                for (int s4 = 0; s4 < 4; ++s4) STb[pl][s4] = pack8(ST[2 * s4][pl][0], ST[2 * s4][pl][1], ST[2 * s4][pl][2], ST[2 * s4][pl][3], ST[2 * s4 + 1][pl][0], ST[2 * s4 + 1][pl][1], ST[2 * s4 + 1][pl][2], ST[2 * s4 + 1][pl][3]);
#pragma unroll
            for (int ci = 0; ci < 4; ++ci)
#pragma unroll
                for (int pl = 0; pl < 2; ++pl) {
                    f32x4 acc = {0.f, 0.f, 0.f, 0.f};
#pragma unroll
                    for (int s4 = 0; s4 < 4; ++s4) acc = MFMA16(ldfrag_perm16(Cs, 136, 16 * ci + fr, s4, q), STb[pl][s4], acc);
#pragma unroll
                    for (int r = 0; r < 4; ++r) acc[r] *= __expf(ac_s[hd * 64 + 16 * ci + 4 * q + r]);
                    Y[ci][pl] = acc;
                }
        }
        GDN_BAR();
        {
            const LAS float* ach = ac_s + hd * 64; const LAS float* dth = dt_s + hd * 64;
#pragma unroll
            for (int ci = 0; ci < 4; ++ci) {
                asm volatile("" ::: "memory");
                const int cc = 16 * ci + fr; const float acc_c = ach[cc];
#pragma unroll
                for (int s2 = 0; s2 < 2; ++s2) {
                    const int e0 = 32 * s2 + 8 * q; float gv[8];
                    const f32x4 c0 = *(const LAS f32x4*)(CBs + cc * 68 + e0), c1 = *(const LAS f32x4*)(CBs + cc * 68 + e0 + 4);
#pragma unroll
                    for (int j = 0; j < 8; ++j) { const int e = e0 + j; const float cbv = j < 4 ? c0[j & 3] : c1[j & 3]; gv[j] = (e <= cc) ? cbv * __expf(acc_c - ach[e]) * dth[e] : 0.f; }
                    const bf16x8 Gf = pack8(gv[0], gv[1], gv[2], gv[3], gv[4], gv[5], gv[6], gv[7]);
#pragma unroll
                    for (int pl = 0; pl < 2; ++pl) Y[ci][pl] = MFMA16(Gf, ldfrag(XTs, 72, hd * 64 + 16 * (2 * e2 + pl) + fr, e0), Y[ci][pl]);
                }
            }
            const float al = ach[63], dc = __expf(al);
            float scv[2][8];
#pragma unroll
            for (int s2 = 0; s2 < 2; ++s2)
#pragma unroll
                for (int j = 0; j < 8; ++j) { const int cidx = 32 * s2 + 8 * q + j; scv[s2][j] = dth[cidx] * __expf(al - ach[cidx]); }
#pragma unroll
            for (int si = 0; si < 8; ++si) {
                asm volatile("" ::: "memory");
                ST[si][0] = ST[si][0] * dc; ST[si][1] = ST[si][1] * dc;
#pragma unroll
                for (int s2 = 0; s2 < 2; ++s2) {
                    const u32x4 bv = *(const LAS u32x4*)(BTs + (16 * si + fr) * 72 + 32 * s2 + 8 * q);
                    const bf16x8 Bf = pack8(bflo(bv.x) * scv[s2][0], bfhi(bv.x) * scv[s2][1], bflo(bv.y) * scv[s2][2], bfhi(bv.y) * scv[s2][3], bflo(bv.z) * scv[s2][4], bfhi(bv.z) * scv[s2][5], bflo(bv.w) * scv[s2][6], bfhi(bv.w) * scv[s2][7]);
#pragma unroll
                    for (int pl = 0; pl < 2; ++pl) ST[si][pl] = MFMA16(Bf, ldfrag(XTs, 72, hd * 64 + 16 * (2 * e2 + pl) + fr, 32 * s2 + 8 * q), ST[si][pl]);
                }
            }
        }
        {
            float part[4][4];
#pragma unroll
            for (int ci = 0; ci < 4; ++ci)
#pragma unroll
                for (int r = 0; r < 4; ++r) {
                    const int cc = 16 * ci + 4 * q + r; float ps = 0.f;
#pragma unroll
                    for (int pl = 0; pl < 2; ++pl) {
                        const int p = 16 * (2 * e2 + pl) + fr;
                        const float x = bf2f(XTs[(hd * 64 + p) * 72 + cc]);
                        const float z = bf2f(PROJ[(size_t)(rowc + cc) * NPROJ + PC_SZ + g * 256 + hd * 64 + p]);
                        const float gz = (Y[ci][pl][r] + dskip * x) * silu_f(z);
                        Y[ci][pl][r] = gz; ps += gz * gz;
                    }
                    ps += __shfl_xor(ps, 1); ps += __shfl_xor(ps, 2); ps += __shfl_xor(ps, 4); ps += __shfl_xor(ps, 8);
                    part[ci][r] = ps;
                }
            if (fr == 0) {
#pragma unroll
                for (int ci = 0; ci < 4; ++ci)
#pragma unroll
                    for (int r = 0; r < 4; ++r) rss[w * 64 + 16 * ci + 4 * q + r] = part[ci][r];
            }
            GDN_BAR();
#pragma unroll
            for (int ci = 0; ci < 4; ++ci)
#pragma unroll
                for (int r = 0; r < 4; ++r) {
                    const int cc = 16 * ci + 4 * q + r; float tot = 0.f;
#pragma unroll
                    for (int ww = 0; ww < 8; ++ww) tot += rss[ww * 64 + cc];
                    const float rstd = rsqrtf(tot * (1.f / 256.f) + 1e-6f);
#pragma unroll
                    for (int pl = 0; pl < 2; ++pl) {
                        const int p = 16 * (2 * e2 + pl) + fr;
                        PROJ[(size_t)(rowc + cc) * NPROJ + PC_SZ + g * 256 + hd * 64 + p] = (bf16_t)f2bf(Y[ci][pl][r] * rstd * nwv[pl]);
                    }
                }
        }
        GDN_BAR();
    }
}

template <bool FINAL>
DI void lru_pass(const Ctx& F, const Args& a, int l, int unit) {
    const int blk = unit & 7, seg = (unit >> 3) & 15, b = unit >> 7;
    const int w = F.wave, lane = F.lane, tid = F.tid, fr = lane & 15, q = lane >> 4;
    bf16_t* PROJ = (bf16_t*)(a.ws + WS_PROJ);
    LAS bf16_t* WAT = (LAS bf16_t*)F.lds;
    LAS bf16_t* WXT = (LAS bf16_t*)(F.lds + 9216);
    LAS bf16_t* XCs = (LAS bf16_t*)(F.lds + 18432);
    LAS float* XF = (LAS float*)(F.lds + 27648);
    LAS float* As = (LAS float*)(F.lds + 44288);
    LAS float* Us = (LAS float*)(F.lds + 60928);
    for (int e8 = tid; e8 < 4096; e8 += 512) {
        const int d = e8 >> 6, e = e8 & 63;
        WAT[e * 72 + d] = (bf16_t)f2bf(a.in[18][((size_t)(l * 8 + blk) * 64 + d) * 64 + e]);
        WXT[e * 72 + d] = (bf16_t)f2bf(a.in[20][((size_t)(l * 8 + blk) * 64 + d) * 64 + e]);
    }
    const int chn = blk * 64 + (tid & 63);
    const int rseg = b * SEQ + seg * 512;
    const int cp = tid & 31, kq = (tid >> 5) & 7, cc2 = blk * 64 + 2 * cp;
    float cw0[4], cw1[4];
#pragma unroll
    for (int k = 0; k < 4; ++k) { cw0[k] = a.in[16][(size_t)(l * 4 + k) * 512 + cc2]; cw1[k] = a.in[16][(size_t)(l * 4 + k) * 512 + cc2 + 1]; }
    const float cb0 = a.in[17][l * 512 + cc2], cb1 = a.in[17][l * 512 + cc2 + 1];
    float hcur = 0.f, pprod = 1.f;
    if (FINAL && w == 0) {
        for (int j = 0; j < seg; ++j) hcur = hcur * ((const float*)(a.ws + WS_LRUP))[(size_t)(b * 16 + j) * 512 + chn] + ((const float*)(a.ws + WS_LRUH))[(size_t)(b * 16 + j) * 512 + chn];
    }
    float ba[2], bx[2], spl[2];
#pragma unroll
    for (int ee = 0; ee < 2; ++ee) { const int ce = blk * 64 + 16 * (2 * (w >> 2) + ee) + fr; ba[ee] = a.in[19][l * 512 + ce]; bx[ee] = a.in[21][l * 512 + ce]; spl[ee] = softplus_f(-a.in[22][l * 512 + ce]); }
    __syncthreads();
    unsigned raw[11], rawn[11];
#pragma unroll
    for (int i = 0; i < 11; ++i) { rawn[i] = 0u; if (tid < 256) { const int lr = 8 * kq - 3 + i; rawn[i] = (seg == 0 && lr < 0) ? 0u : *(const unsigned*)(PROJ + (size_t)(rseg + lr) * NPROJ + PC_LX + cc2); } }
    for (int ch = 0; ch < 8; ++ch) {
        const int rowc = rseg + ch * 64;
#pragma unroll
        for (int i = 0; i < 11; ++i) raw[i] = rawn[i];
        if (ch + 1 < 8 && tid < 256) {
#pragma unroll
            for (int i = 0; i < 11; ++i) rawn[i] = *(const unsigned*)(PROJ + (size_t)(rowc + 64 + 8 * kq - 3 + i) * NPROJ + PC_LX + cc2);
        }
        u32x4 gpre = {0u, 0u, 0u, 0u};
        if (FINAL) gpre = *(const u32x4*)(PROJ + (size_t)(rowc + (tid >> 3)) * NPROJ + PC_LG + blk * 64 + (tid & 7) * 8);
        if (tid < 256) {
#pragma unroll
            for (int i = 0; i < 8; ++i) {
                const float a0 = cw0[0] * bflo(raw[i]) + cw0[1] * bflo(raw[i + 1]) + cw0[2] * bflo(raw[i + 2]) + cw0[3] * bflo(raw[i + 3]) + cb0;
                const float a1 = cw1[0] * bfhi(raw[i]) + cw1[1] * bfhi(raw[i + 1]) + cw1[2] * bfhi(raw[i + 2]) + cw1[3] * bfhi(raw[i + 3]) + cb1;
                const int r = 8 * kq + i;
                *(LAS unsigned*)(XCs + r * 72 + 2 * cp) = pk2(a0, a1); XF[r * 65 + 2 * cp] = a0; XF[r * 65 + 2 * cp + 1] = a1;
            }
        }
        GDN_BAR();
        {
            const int ci = w & 3;
#pragma unroll
            for (int ee = 0; ee < 2; ++ee) {
                const int ej = 2 * (w >> 2) + ee; f32x4 aa = {0.f, 0.f, 0.f, 0.f}, ax = {0.f, 0.f, 0.f, 0.f};
#pragma unroll
                for (int s = 0; s < 2; ++s) { const bf16x8 xf = ldfrag(XCs, 72, 16 * ci + fr, 32 * s + 8 * q);
                    aa = MFMA16(xf, ldfrag(WAT, 72, 16 * ej + fr, 32 * s + 8 * q), aa); ax = MFMA16(xf, ldfrag(WXT, 72, 16 * ej + fr, 32 * s + 8 * q), ax); }
#pragma unroll
                for (int r = 0; r < 4; ++r) {
                    const int cc = 16 * ci + 4 * q + r, e = 16 * ej + fr;
                    const float rg = sigmoid_f(aa[r] + ba[ee]), ig = sigmoid_f(ax[r] + bx[ee]);
                    const float la = -8.0f * rg * spl[ee];
                    As[cc * 65 + e] = __expf(la); Us[cc * 65 + e] = sqrtf(neg_expm1_small(2.0f * la)) * ig * XF[cc * 65 + e];
                }
            }
        }
        GDN_BAR();
        if (w == 0) {
            float av[64], uv[64];
#pragma clang loop unroll(full)
            for (int i = 0; i < 64; ++i) { av[i] = As[i * 65 + lane]; uv[i] = Us[i * 65 + lane]; }
            __builtin_amdgcn_sched_barrier(0);
#pragma clang loop unroll(full)
            for (int i = 0; i < 64; ++i) { hcur = av[i] * hcur + uv[i]; pprod *= av[i]; uv[i] = hcur; }
            if (FINAL) {
#pragma clang loop unroll(full)
                for (int i = 0; i < 64; ++i) As[i * 65 + lane] = uv[i];
            }
        }
        if (FINAL) {
            GDN_BAR();
            const int cc = tid >> 3, e8 = (tid & 7) * 8;
            bf16_t* gp = PROJ + (size_t)(rowc + cc) * NPROJ + PC_LG + blk * 64 + e8;
            const u32x4 gv = gpre; const unsigned gg[4] = {gv.x, gv.y, gv.z, gv.w}; unsigned oo[4];
#pragma unroll
            for (int j = 0; j < 4; ++j) oo[j] = pk2(As[cc * 65 + e8 + 2 * j] * gelu_tanh_f(bflo(gg[j])), As[cc * 65 + e8 + 2 * j + 1] * gelu_tanh_f(bfhi(gg[j])));
            *(u32x4*)gp = (u32x4){oo[0], oo[1], oo[2], oo[3]};
        }
        GDN_BAR();
    }
    if (!FINAL && w == 0) {
        ((float*)(a.ws + WS_LRUP))[(size_t)(b * 16 + seg) * 512 + chn] = pprod;
        ((float*)(a.ws + WS_LRUH))[(size_t)(b * 16 + seg) * 512 + chn] = hcur;
    }
}


__global__ void __launch_bounds__(512, 2) mega_fwd(Args args) {
    extern __shared__ __attribute__((aligned(16))) unsigned char lds_raw[];
    LAS unsigned char* const ldsp = (LAS unsigned char*)lds_raw;
#define F make_ctx(ldsp)
    const int lo = args.ph_lo, hi = args.ph_hi;
    unsigned char* ws = args.ws;
    float* MOD = (float*)(ws + WS_MOD);
    bf16_t* XN = (bf16_t*)(ws + WS_XN); bf16_t* PROJ = (bf16_t*)(ws + WS_PROJ); bf16_t* MERGED = (bf16_t*)(ws + WS_MERGED);
#define IN(k) (lo <= (k) && (k) < hi)
    LAS unsigned long long* prs = (LAS unsigned long long*)(ldsp + 163824);
    if (PROBE_A >= 0 && threadIdx.x == 0) { prs[0] = 0ull; prs[1] = 0ull; }
#define STAMP(id) do { if (PROBE_A >= 0 && ((id) == PROBE_A || (id) == PROBE_B) && blockIdx.x == PROBE_BLK && threadIdx.x == 0) { const unsigned long long t_ = __builtin_amdgcn_s_memrealtime(); if ((id) == PROBE_A) prs[1] = t_; if ((id) == PROBE_B) prs[0] += t_ - prs[1]; } } while (0)
    volatile LAS unsigned* xst = (volatile LAS unsigned*)(ldsp + 163808);
    if (threadIdx.x == 0) { xst[0] = 0u; xst[1] = 0u; }
    __syncthreads();
    XcdBarrier xbar; xbar.bar = (unsigned*)(ws + WS_BAR); xbar.x = 0; xbar.st = xst;
    if (hi - lo > 1) xbar = xcd_barrier_post((unsigned*)(ws + WS_BAR), xst);
    if (hi > 1000) { __threadfence(); cg::this_grid().sync(); }
#define SEAM(k) do { if (IN(k) && IN((k) + 1)) xcd_barrier(xbar); } while (0)
    STAMP(40);
    if (IN(0)) { for (int rep = 0; rep < REP_B; ++rep) phase_p0(F, args); }
    SEAM(0);
    STAMP(41);
#pragma unroll 1
    for (int l = 0; l < 2; ++l) {
        const int base = 1 + 9 * l;
        const float* modl = MOD + (size_t)l * 4 * 6144;
        const bf16_t* wl = (const bf16_t*)(ws + WS_W) + (size_t)l * WO_LAYER;
        const float* xcur = l == 0 ? args.in[0] : args.out;
        STAMP(0);
        if (IN(base + 0)) for (int rep = 0; rep < REP_B; ++rep) phase_norm<true>(F, xcur, args.in[4] + l * DM, modl, 0, 1024, XN, (const float*)(ws + WS_WSM) + (size_t)l * 16 * 1024, (float*)(ws + WS_SMALL));
        STAMP(1);
        SEAM(base + 0);
        STAMP(2);
        if (IN(base + 1)) for (int rep = 0; rep < REP_A; ++rep) {
            pg8::Gemm g{XN, wl + WO_IN, MTOK, NPROJ, DM, DM, DM}; pg8::StaticOrder S; S.init(MTOK, NPROJ, F.G, F.bid);
            pg8::EpiProj E{PROJ, (bf16_t*)(ws + WS_TAIL)};
            pg8::gemm_phase(F.lds, g, S, E);
        }
        STAMP(3);
        SEAM(base + 1);
        STAMP(4);
        if (IN(base + 2)) {
            for (int u = F.bid; u < 2048; u += F.G) { STAMP(24); gdn_prep_unit(F, args, l, u); STAMP(25); __syncthreads(); }
        }
        STAMP(5);
        SEAM(base + 2);
        STAMP(6);
        if (IN(base + 3)) {
            if (F.bid < 16) gdn_seq(F, args, l, F.bid, xbar);
            else {
                const int j = F.bid - 16, NJ = F.G - 16;
                for (int u = j; u < 1024; u += NJ) {
                    if (u < 512) { STAMP(20); ssd_pass_a(F, args, l, u); STAMP(21); } else { STAMP(22); lru_pass<false>(F, args, l, u - 512); STAMP(23); }
                    __syncthreads();
                }
                xcd_barrier(xbar);
                if (j < 128) { STAMP(26); ssd_pass_c(F, args, l, j); STAMP(27); __syncthreads(); lru_pass<true>(F, args, l, j); __syncthreads(); }
                else { for (int u = 128 + (j - 128); u < 512; u += NJ - 128) { STAMP(28); lru_pass<true>(F, args, l, u); STAMP(29); __syncthreads(); } }
                if (l == 0) convert_weights(F, args, 1, j * 8 + F.wave, NJ * 8);
            }
        }
        STAMP(7);
        SEAM(base + 3);
        STAMP(8);
        if (IN(base + 4)) for (int rep = 0; rep < REP_A; ++rep) {
            gdn_post(F, args, l);
            pg8::StaticOrder S; S.init(MTOK, DM, F.G, F.bid);
            { pg8::GateOrder GO{S}; pg8::Gemm g{XN, wl + WO_GATE, MTOK, 3 * DM, DM, DM, DM}; pg8::EpiGate E{PROJ}; pg8::gemm_phase(F.lds, g, GO, E); }
            xcd_barrier(xbar);
            { pg8::BranchOrder BO{S}; pg8::Gemm g{PROJ, wl + WO_BR, MTOK, DM, 512, NPROJ, 512}; pg8::EpiBranch E{PROJ, MERGED}; pg8::gemm_phase(F.lds, g, BO, E); }
        }
        STAMP(9);
        SEAM(base + 4);
        STAMP(10);
        if (IN(base + 5)) {
            pg8::Gemm g{MERGED, wl + WO_OUT, MTOK, DM, DM, DM, DM}; pg8::StaticOrder S; S.init(MTOK, DM, F.G, F.bid);
            pg8::EpiResid E{xcur, args.out, modl + 2048};
            pg8::gemm_phase(F.lds, g, S, E);
        }
        STAMP(11);
        SEAM(base + 5);
        STAMP(12);
        if (IN(base + 6)) for (int rep = 0; rep < REP_B; ++rep) phase_norm<false>(F, args.out, args.in[25] + l * DM, modl, 3072, 4096, XN, nullptr, nullptr);
        STAMP(13);
        SEAM(base + 6);
        STAMP(14);
        if (IN(base + 7)) for (int rep = 0; rep < REP_A; ++rep) {
            pg8::Gemm g{XN, wl + WO_UP, MTOK, DFF, DM, DM, DM}; pg8::StaticOrder S; S.init(MTOK, DFF, F.G, F.bid);
            pg8::EpiUp E{PROJ};
            pg8::gemm_phase(F.lds, g, S, E);
        }
        STAMP(15);
        SEAM(base + 7);
        STAMP(16);
        if (IN(base + 8)) {
            pg8::Gemm g{PROJ, wl + WO_DOWN, MTOK, DM, DFF, DFF, DFF}; pg8::StaticOrder S; S.init(MTOK, DM, F.G, F.bid);
            pg8::EpiResid E{args.out, args.out, modl + 5120};
            pg8::gemm_phase(F.lds, g, S, E);
        }
        STAMP(17);
        SEAM(base + 8);
        STAMP(18);
    }
    if (IN(19)) phase_final_norm(F, args.out, args.in[28]);
    if (PROBE_A >= 0 && blockIdx.x == PROBE_BLK && threadIdx.x == 0) { const unsigned long long te = __builtin_amdgcn_s_memrealtime(); const unsigned long long dd = PROBE_K * prs[0]; while (__builtin_amdgcn_s_memrealtime() - te < dd) __builtin_amdgcn_s_sleep(8); }
#undef IN
#undef SEAM
}

extern "C" void kernel_launch(void* const* d_in, const int* in_sizes, int n_in, void* d_out, int out_size, void* d_ws, size_t ws_size, hipStream_t stream) {
    static int grid = 0;
    if (grid == 0) {
        if (n_in != 29 || out_size != MTOK * DM || ws_size < WS_END) { fprintf(stderr, "kernel_launch: unexpected problem (n_in %d out %d ws %zu)\n", n_in, out_size, ws_size); grid = -1; return; }
        int dev = 0, cus = 0, per_cu = 0;
        hipGetDevice(&dev); hipDeviceGetAttribute(&cus, hipDeviceAttributeMultiprocessorCount, dev);
        if (hipFuncSetAttribute((const void*)mega_fwd, hipFuncAttributeMaxDynamicSharedMemorySize, LDS_BYTES) != hipSuccess) { fprintf(stderr, "kernel_launch: hipFuncSetAttribute failed\n"); grid = -1; return; }
        if (hipOccupancyMaxActiveBlocksPerMultiprocessor(&per_cu, (const void*)mega_fwd, 512, LDS_BYTES) != hipSuccess || per_cu < 1) { fprintf(stderr, "kernel_launch: occupancy query says %d\n", per_cu); per_cu = 1; }
        (void)hipGetLastError();
        grid = cus * per_cu;
    }
    if (grid < 0) return;
    Args a{};
    for (int i = 0; i < 29; ++i) a.in[i] = (const float*)d_in[i];
    a.out = (float*)d_out; a.ws = (unsigned char*)d_ws;
    (void)hipMemsetAsync((char*)d_ws + WS_BAR, 0, XCD_BAR_WORDS * 4, stream);
#if MK_SINGLE
    a.ph_lo = 0; a.ph_hi = 20;
    void* kargs[] = {&a};
    hipError_t e = hipLaunchCooperativeKernel((const void*)mega_fwd, dim3(grid), dim3(512), kargs, LDS_BYTES, stream);
    if (e != hipSuccess) fprintf(stderr, "cooperative launch failed: %s (grid %d)\n", hipGetErrorString(e), grid);
#else
    for (int p = 0; p < 20; ++p) {
        a.ph_lo = p; a.ph_hi = p + 1;
        hipLaunchKernelGGL(mega_fwd, dim3(grid), dim3(512), LDS_BYTES, stream, a);
    }
#endif
}
```

```cpp
#include <hip/hip_runtime.h>
#include <hip/hip_cooperative_groups.h>
#include <cstdio>
#include <cstdint>
namespace cg = cooperative_groups;

#define LAS __attribute__((address_space(3)))
typedef unsigned short bf16_t;
typedef short bf16x8 __attribute__((ext_vector_type(8)));
typedef short s16x4 __attribute__((ext_vector_type(4)));
typedef float f32x4 __attribute__((ext_vector_type(4)));
typedef float f32x16 __attribute__((ext_vector_type(16)));
typedef unsigned u32x4 __attribute__((ext_vector_type(4)));
typedef unsigned u32x2 __attribute__((ext_vector_type(2)));
#define DI __device__ __forceinline__

#ifndef REP_A
#define REP_A 1
#endif
#ifndef REP_B
#define REP_B 1
#endif
#ifndef PROBE_A
#define PROBE_A -1
#define PROBE_B -1
#endif
#define PROBE_K 4
#ifndef PROBE_BLK
#define PROBE_BLK 0
#endif
#ifndef MK_SINGLE
#define MK_SINGLE 1
#endif

constexpr int DM = 1024, SEQ = 8192, MTOK = 32768, NPROJ = 4608, DFF = 4096, DIN = 7696;
constexpr int PC_Q = 0, PC_K = 512, PC_V = 1024, PC_GZ = 1536, PC_SX = 2048, PC_SZ = 2560, PC_BM = 3072, PC_CM = 3328, PC_LX = 3584, PC_LG = 4096;
constexpr size_t MiB = 1u << 20;
constexpr size_t WS_MOD = 0;
constexpr size_t WS_WSM = 256 * 1024;
constexpr size_t WS_GC = 1 * MiB;
constexpr size_t WS_LSEG = 1 * MiB + 512 * 1024;
constexpr size_t WS_LRUP = WS_LSEG + 4096;
constexpr size_t WS_LRUH = WS_LRUP + 128 * 1024;
constexpr size_t WS_SMALL = 2 * MiB;
constexpr size_t WS_TAIL = 4 * MiB;
constexpr size_t WS_W = 9 * MiB;
constexpr size_t WS_XN = 81 * MiB;
constexpr size_t WS_PROJ = 145 * MiB;
constexpr size_t WS_KDT = 433 * MiB;
constexpr size_t WS_QK = 465 * MiB;
constexpr size_t WS_SSEG = 481 * MiB;
constexpr size_t WS_MERGED = 433 * MiB;
constexpr size_t WS_END = 497 * MiB;
constexpr size_t WO_IN = 0, WO_GATE = 4718592, WO_BR = WO_GATE + 3145728, WO_OUT = WO_BR + 1572864, WO_UP = WO_OUT + 1048576, WO_DOWN = WO_UP + 4194304, WO_LAYER = WO_DOWN + 4194304;
constexpr int LDS_BYTES = 163840;

typedef float f32x2_t __attribute__((ext_vector_type(2)));
typedef __bf16 bf16x2_t __attribute__((ext_vector_type(2)));
DI unsigned pk2(float lo, float hi) { f32x2_t v; v.x = lo; v.y = hi; return __builtin_bit_cast(unsigned, __builtin_convertvector(v, bf16x2_t)); }
DI unsigned f2bf(float f) { return pk2(f, 0.f) & 0xffffu; }
DI float bf2f(unsigned short v) { return __builtin_bit_cast(float, (unsigned)v << 16); }
DI float bflo(unsigned v) { return __builtin_bit_cast(float, v << 16); }
DI float bfhi(unsigned v) { return __builtin_bit_cast(float, v & 0xffff0000u); }
DI float sigmoid_f(float x) { return __builtin_amdgcn_rcpf(1.f + __expf(-x)); }
DI float silu_f(float x) { return x * __builtin_amdgcn_rcpf(1.f + __expf(-x)); }
DI float softplus_f(float x) { return fmaxf(x, 0.f) + __logf(1.f + __expf(-fabsf(x))); }
DI float neg_expm1_small(float x) { return -x * (1.f + x * (0.5f + x * (0.16666667f + x * (0.041666668f + x * 0.0083333333f)))); }
DI float gelu_tanh_f(float x) { const float u = 0.7978845608028654f * (x + 0.044715f * x * x * x); const float t = 1.f - 2.f * __builtin_amdgcn_rcpf(1.f + __expf(2.f * u)); return 0.5f * x * (1.f + t); }
DI float wave_sum(float v) {
#pragma unroll
    for (int o = 1; o < 64; o <<= 1) v += __shfl_xor(v, o);
    return v;
}
DI float wave_incl_scan(float v, int lane) {
#pragma unroll
    for (int o = 1; o < 64; o <<= 1) { const float t = __shfl_up(v, o); if (lane >= o) v += t; }
    return v;
}
DI bf16x8 pack8(float a0, float a1, float a2, float a3, float a4, float a5, float a6, float a7) {
    u32x4 p; p.x = pk2(a0, a1); p.y = pk2(a2, a3); p.z = pk2(a4, a5); p.w = pk2(a6, a7); return __builtin_bit_cast(bf16x8, p);
}
DI bf16x8 cat4(s16x4 lo, s16x4 hi) { return __builtin_shufflevector(lo, hi, 0, 1, 2, 3, 4, 5, 6, 7); }
#define MFMA16(a, b, c) __builtin_amdgcn_mfma_f32_16x16x32_bf16((a), (b), (c), 0, 0, 0)
#define MFMA32(a, b, c) __builtin_amdgcn_mfma_f32_32x32x16_bf16((a), (b), (c), 0, 0, 0)
DI bf16x8 ldfrag(const LAS bf16_t* base, int pitch, int row, int k0) { return *(const LAS bf16x8*)(base + row * pitch + k0); }
DI bf16x8 ldfrag_perm16(const LAS bf16_t* base, int pitch, int row, int s, int q) {
    const LAS bf16_t* p = base + row * pitch + 32 * s + 4 * q; return cat4(*(const LAS s16x4*)p, *(const LAS s16x4*)(p + 16));
}
DI s16x4 ldg8(const void* base, unsigned off) { return *(const s16x4*)((const char*)base + off); }
DI bf16x8 ldg8x2(const void* base, unsigned off) { return cat4(ldg8(base, off), ldg8(base, off + 16u)); }
DI int crow(int r, int hh) { return (r & 3) + 8 * (r >> 2) + 4 * hh; }

#define GDN_BAR() do { asm volatile("s_waitcnt lgkmcnt(0)" ::: "memory"); __builtin_amdgcn_s_barrier(); asm volatile("" ::: "memory"); } while (0)
#define SCHEDB() __builtin_amdgcn_sched_barrier(0)
struct Ctx { LAS unsigned char* lds; int tid, lane, wave, G, bid; };
DI Ctx make_ctx(LAS unsigned char* lds) { Ctx F; int t = threadIdx.x; asm volatile("" : "+v"(t)); F.lds = lds; F.tid = t; F.lane = t & 63; F.wave = __builtin_amdgcn_readfirstlane(t >> 6); F.G = gridDim.x; F.bid = blockIdx.x; return F; }
struct Args { const float* in[29]; float* out; unsigned char* ws; int ph_lo, ph_hi; };

namespace pg8 {
constexpr int BM = 256, BK = 64, HALF = 128, HTB = HALF * BK * 2, STAGE_BYTES = 8 * HTB, NXCD = 8, WGM = 8;
DI int lds_byte(int r, int c) { const int st = (r >> 4) * 2 + (c >> 5), rr = r & 15, cc = c & 31, ob = rr * 64 + cc * 2; return st * 1024 + (ob ^ (((ob >> 9) & 1) << 5)); }
DI int perm32(int rho) { const int n = rho >> 4, i = rho & 15; return 8 * (i >> 2) + 4 * n + (i & 3); }
DI void stage_rc(int b, int& R, int& C) { const int st = b / 1024, sb = b % 1024, swz = sb ^ (((sb >> 9) & 1) << 5); R = (st >> 1) * 16 + swz / 64; C = (st & 1) * 32 + (swz % 64) / 2; }
struct Unit { int pm, pn, r; long aoff, boff; };
struct Gemm { const bf16_t* A; const bf16_t* Bt; int M, N, K, lda, ldb; };
struct StaticOrder {
    int nM, nN, nwg, G, c;
    DI void init(int M, int N, int G_, int c_) { nM = M / BM; nN = N / BM; nwg = nM * nN; G = G_; c = c_; }
    DI bool next(int i, Unit& u) const {
        const long L = (long)i * G + c; if (L >= nwg) return false;
        int wgid = (int)L; { const int q = nwg / NXCD, r = nwg % NXCD, xcd = wgid % NXCD, off = wgid / NXCD; wgid = (xcd < r ? xcd * (q + 1) : r * (q + 1) + (xcd - r) * q) + off; }
        const int nig = WGM * nN, gid = wgid / nig, fm = gid * WGM, gsz = (nM - fm) < WGM ? (nM - fm) : WGM;
        u.pm = fm + ((wgid % nig) % gsz); u.pn = (wgid % nig) / gsz; u.r = 0; u.aoff = 0; u.boff = 0; return true;
    }
};
struct GateOrder {
    StaticOrder so;
    DI bool next(int i, Unit& u) const { if (!so.next(i / 3, u)) return false; const int r = i % 3; u.r = r; u.pn = 4 * r + u.pn; return true; }
};
struct BranchOrder {
    StaticOrder so;
    DI bool next(int i, Unit& u) const { if (!so.next(i / 3, u)) return false; const int r = i % 3; u.r = r;
        u.aoff = (long)(r == 0 ? PC_GZ : (r == 1 ? PC_SZ : PC_LG)) * 2; u.boff = (long)r * DM * 512 * 2; return true; }
};
template <class Epi, class Sched>
DI void gemm_phase(LAS unsigned char* lds, const Gemm g, const Sched& S, const Epi& E) {
    int tid_ = threadIdx.x; asm volatile("" : "+v"(tid_)); const int tid = tid_, wid = __builtin_amdgcn_readfirstlane(tid >> 6), lane = tid & 63, wr = wid >> 2, wc = wid & 3, fr = lane & 15, fq = lane >> 4;
    const int K = g.K, nt = K / BK;
    unsigned voffA[2], voffB[2];
#pragma unroll
    for (int i = 0; i < 2; ++i) { int R, C; stage_rc(tid * 16 + i * 8192, R, C); const int Rb = (R & ~31) + perm32(R & 31); voffA[i] = (unsigned)(R * g.lda + C) * 2u; voffB[i] = (unsigned)(Rb * g.ldb + C) * 2u; }
    const size_t kstep = (size_t)(BK * 2);
    const size_t hstepA = (size_t)HALF * g.lda * 2, hstepB = (size_t)HALF * g.ldb * 2;
    const size_t tstepA = 2 * hstepA, tstepB = 2 * hstepB;
    const unsigned ldsw = (unsigned)wid * 1024u;
    const int aoff = lds_byte(wr * 64 + fr, fq * 8), boff = lds_byte(wc * 32 + fr, fq * 8);
#define PG8_SA(b, h) (((b) * 2 + (h)) * HTB)
#define PG8_SB(b, h) ((4 + (b) * 2 + (h)) * HTB)
#define PG8_STAGE(bufoff, gbase, voff) do { _Pragma("unroll") for (int _i = 0; _i < 2; ++_i) \
        __builtin_amdgcn_global_load_lds((const unsigned*)((const char*)(gbase) + (voff)[_i]), (LAS unsigned*)(lds + (bufoff) + ldsw + _i * 8192), 16, 0, 0); } while (0)
#define PG8_LDA(dst, b, h) do { _Pragma("unroll") for (int m = 0; m < 4; ++m) _Pragma("unroll") for (int k = 0; k < 2; ++k) dst[m][k] = *(const LAS bf16x8*)(lds + PG8_SA(b, h) + aoff + m * 2048 + k * 1024); } while (0)
#define PG8_LDB(dst, b, h) do { _Pragma("unroll") for (int n = 0; n < 2; ++n) _Pragma("unroll") for (int k = 0; k < 2; ++k) dst[n][k] = *(const LAS bf16x8*)(lds + PG8_SB(b, h) + boff + n * 2048 + k * 1024); } while (0)
#define PG8_MMA(ai, bj, At, Bt) do { __builtin_amdgcn_s_setprio(1); _Pragma("unroll") for (int m = 0; m < 4; ++m) _Pragma("unroll") for (int n = 0; n < 2; ++n) _Pragma("unroll") for (int k = 0; k < 2; ++k) \
        acc[ai][bj][m][n] = __builtin_amdgcn_mfma_f32_16x16x32_bf16(Bt[n][k], At[m][k], acc[ai][bj][m][n], 0, 0, 0); __builtin_amdgcn_s_setprio(0); } while (0)
#define PG8_WAIT_V(n) asm volatile("s_waitcnt vmcnt(" #n ")" ::: "memory")
#define PG8_WAIT_L(n) asm volatile("s_waitcnt lgkmcnt(" #n ")" ::: "memory")
#define PG8_BAR __builtin_amdgcn_s_barrier()
#define PG8_SCHED __builtin_amdgcn_sched_barrier(0)
    Unit cur, nxt; int ui = 0;
    if (!S.next(0, cur)) return;
    f32x4 acc[2][2][4][2];
#pragma unroll
    for (int a = 0; a < 2; ++a)
#pragma unroll
        for (int b = 0; b < 2; ++b)
#pragma unroll
            for (int m = 0; m < 4; ++m)
#pragma unroll
                for (int n = 0; n < 2; ++n) acc[a][b][m][n] = (f32x4){0.f, 0.f, 0.f, 0.f};
    bf16x8 At[4][2], B0[2][2], B1[2][2];
    const char* cA = (const char*)g.A + (size_t)cur.pm * tstepA + cur.aoff; const char* cB = (const char*)g.Bt + (size_t)cur.pn * tstepB + cur.boff;
    PG8_STAGE(PG8_SB(0, 0), cB, voffB); PG8_STAGE(PG8_SB(0, 1), cB + hstepB, voffB); PG8_STAGE(PG8_SA(0, 0), cA, voffA); PG8_STAGE(PG8_SA(0, 1), cA + hstepA, voffA);
    if (wr == 1) PG8_BAR;
    PG8_WAIT_V(2); PG8_BAR;
    PG8_STAGE(PG8_SB(1, 0), cB + kstep, voffB); PG8_STAGE(PG8_SA(1, 0), cA + kstep, voffA); PG8_STAGE(PG8_SB(1, 1), cB + hstepB + kstep, voffB);
    PG8_WAIT_V(6); PG8_BAR;
    for (;;) {
        const bool has_next = S.next(ui + 1, nxt);
        const char* nA = has_next ? (const char*)g.A + (size_t)nxt.pm * tstepA + nxt.aoff : cA; const char* nB = has_next ? (const char*)g.Bt + (size_t)nxt.pn * tstepB + nxt.boff : cB;
        for (int t = 0; t < nt; t += 2) {
            const bool last = (t == nt - 2);
            const char* a1 = cA + (size_t)(t + 1) * kstep;
            const char* a2 = last ? nA : cA + (size_t)(t + 2) * kstep; const char* b2 = last ? nB : cB + (size_t)(t + 2) * kstep;
            const char* a3 = a2 + kstep; const char* b3 = b2 + kstep;
            PG8_LDB(B0, 0, 0); PG8_LDB(B1, 0, 1); PG8_SCHED; PG8_LDA(At, 0, 0); PG8_STAGE(PG8_SA(1, 1), a1 + hstepA, voffA);
            PG8_WAIT_V(8); PG8_WAIT_L(0); PG8_BAR; PG8_MMA(0, 0, At, B0); PG8_MMA(0, 1, At, B1); PG8_BAR; PG8_SCHED;
            PG8_LDA(At, 0, 1); PG8_STAGE(PG8_SB(0, 0), b2, voffB); PG8_STAGE(PG8_SB(0, 1), b2 + hstepB, voffB); PG8_STAGE(PG8_SA(0, 0), a2, voffA);
            PG8_WAIT_V(8); PG8_WAIT_L(0); PG8_BAR; PG8_MMA(1, 0, At, B0); PG8_MMA(1, 1, At, B1); PG8_BAR; PG8_SCHED;
            PG8_LDB(B0, 1, 0); PG8_LDB(B1, 1, 1); PG8_SCHED; PG8_LDA(At, 1, 0); PG8_STAGE(PG8_SA(0, 1), a2 + hstepA, voffA);
            PG8_WAIT_V(8); PG8_WAIT_L(0); PG8_BAR; PG8_MMA(0, 0, At, B0); PG8_MMA(0, 1, At, B1); PG8_BAR; PG8_SCHED;
            PG8_LDA(At, 1, 1); PG8_STAGE(PG8_SB(1, 0), b3, voffB); PG8_STAGE(PG8_SB(1, 1), b3 + hstepB, voffB); PG8_STAGE(PG8_SA(1, 0), a3, voffA);
            PG8_WAIT_V(8); PG8_WAIT_L(0); PG8_BAR; PG8_MMA(1, 0, At, B0); PG8_MMA(1, 1, At, B1); PG8_BAR; PG8_SCHED;
        }
        if (wr == 0) PG8_BAR;
        E(acc, cur, wr, wc, fr, fq);
        if (!has_next) break;
#pragma unroll
        for (int a = 0; a < 2; ++a)
#pragma unroll
            for (int b = 0; b < 2; ++b)
#pragma unroll
                for (int m = 0; m < 4; ++m)
#pragma unroll
                    for (int n = 0; n < 2; ++n) acc[a][b][m][n] = (f32x4){0.f, 0.f, 0.f, 0.f};
        cur = nxt; cA = nA; cB = nB; ++ui;
        if (wr == 1) PG8_BAR;
    }
    PG8_WAIT_V(0);
    PG8_BAR;
#undef PG8_SA
#undef PG8_SB
#undef PG8_STAGE
#undef PG8_LDA
#undef PG8_LDB
#undef PG8_MMA
#undef PG8_WAIT_V
#undef PG8_WAIT_L
#undef PG8_BAR
#undef PG8_SCHED
}
#define PG8_FOREACH(body) \
    _Pragma("unroll") for (int ai = 0; ai < 2; ++ai) _Pragma("unroll") for (int m = 0; m < 4; ++m) { const int row = u.pm * BM + ai * HALF + wr * 64 + m * 16 + fr; \
    _Pragma("unroll") for (int bj = 0; bj < 2; ++bj) _Pragma("unroll") for (int n = 0; n < 2; ++n) { const int col = u.pn * BM + bj * HALF + wc * 32 + 4 * n + 8 * fq; const f32x4 v = acc[ai][bj][m][n]; body } }

struct EpiProj {
    bf16_t* P; bf16_t* tail;
    DI void operator()(const f32x4 (&acc)[2][2][4][2], const Unit& u, int wr, int wc, int fr, int fq) const {
        PG8_FOREACH({ u32x2 w; w.x = pk2(v[0], v[1]); w.y = pk2(v[2], v[3]); *(u32x2*)(P + (size_t)row * NPROJ + col) = w;
            if (col < 1536 && (row & 63) >= 61) *(u32x2*)(tail + ((size_t)(row >> 6) * 3 + ((row & 63) - 61)) * 1536 + col) = w; })
    }
};
DI int gt_col(int t) { return t < 6 ? 256 * t : (t < 8 ? 2048 + 256 * (t - 6) : 3072 + 256 * (t - 8)); }
struct EpiGate {
    bf16_t* P;
    DI void operator()(const f32x4 (&acc)[2][2][4][2], const Unit& u, int wr, int wc, int fr, int fq) const {
        const int cb = gt_col(u.pn);
#pragma unroll
        for (int ai = 0; ai < 2; ++ai)
#pragma unroll
            for (int m = 0; m < 4; ++m) { const int row = u.pm * BM + ai * HALF + wr * 64 + m * 16 + fr;
#pragma unroll
                for (int bj = 0; bj < 2; ++bj)
#pragma unroll
                    for (int n = 0; n < 2; ++n) { const int col = cb + bj * HALF + wc * 32 + 4 * n + 8 * fq; const f32x4 v = acc[ai][bj][m][n];
                        u32x2 w; w.x = pk2(sigmoid_f(v[0]), sigmoid_f(v[1])); w.y = pk2(sigmoid_f(v[2]), sigmoid_f(v[3])); *(u32x2*)(P + (size_t)row * NPROJ + col) = w; } }
    }
};
struct EpiBranch {
    const bf16_t* GT; bf16_t* Mg;
    DI void operator()(const f32x4 (&acc)[2][2][4][2], const Unit& u, int wr, int wc, int fr, int fq) const {
        const int cb = gt_col(4 * u.r + u.pn); const bool first = (u.r == 0);
#pragma unroll
        for (int ai = 0; ai < 2; ++ai) {
            u32x4 gg[4][2], mm[4][2];
#pragma unroll
            for (int m = 0; m < 4; ++m) { const int row = u.pm * BM + ai * HALF + wr * 64 + m * 16 + fr;
#pragma unroll
                for (int bj = 0; bj < 2; ++bj) { const int co = bj * HALF + wc * 32 + 8 * fq;
                    gg[m][bj] = *(const u32x4*)(GT + (size_t)row * NPROJ + cb + co);
                    mm[m][bj] = first ? (u32x4){0u, 0u, 0u, 0u} : *(const u32x4*)(Mg + (size_t)row * DM + u.pn * BM + co); } }
            __builtin_amdgcn_sched_barrier(0);
#pragma unroll
            for (int m = 0; m < 4; ++m) { const int row = u.pm * BM + ai * HALF + wr * 64 + m * 16 + fr;
#pragma unroll
                for (int bj = 0; bj < 2; ++bj) { const int co = bj * HALF + wc * 32 + 8 * fq; const f32x4 v0 = acc[ai][bj][m][0], v1 = acc[ai][bj][m][1]; const u32x4 g4 = gg[m][bj], m4 = mm[m][bj];
                    u32x4 w; w.x = pk2(bflo(g4.x) * v0[0] + bflo(m4.x), bfhi(g4.x) * v0[1] + bfhi(m4.x)); w.y = pk2(bflo(g4.y) * v0[2] + bflo(m4.y), bfhi(g4.y) * v0[3] + bfhi(m4.y));
                    w.z = pk2(bflo(g4.z) * v1[0] + bflo(m4.z), bfhi(g4.z) * v1[1] + bfhi(m4.z)); w.w = pk2(bflo(g4.w) * v1[2] + bflo(m4.w), bfhi(g4.w) * v1[3] + bfhi(m4.w));
                    *(u32x4*)(Mg + (size_t)row * DM + u.pn * BM + co) = w; } }
        }
    }
};
struct EpiResid {
    const float* xin; float* xout; const float* gate;
    DI void operator()(const f32x4 (&acc)[2][2][4][2], const Unit& u, int wr, int wc, int fr, int fq) const {
        const int b = (u.pm * BM) >> 13; f32x4 gv[2][2];
#pragma unroll
        for (int bj = 0; bj < 2; ++bj)
#pragma unroll
            for (int n = 0; n < 2; ++n) gv[bj][n] = *(const f32x4*)(gate + b * 6144 + u.pn * BM + bj * HALF + wc * 32 + 4 * n + 8 * fq);
#pragma unroll
        for (int aim = 0; aim < 4; ++aim) { const int ai = aim >> 1, m0 = 2 * (aim & 1);
            f32x4 xv[4][2][2];
#pragma unroll
            for (int m = m0; m < m0 + 2; ++m) { const int row = u.pm * BM + ai * HALF + wr * 64 + m * 16 + fr;
#pragma unroll
                for (int bj = 0; bj < 2; ++bj)
#pragma unroll
                    for (int n = 0; n < 2; ++n) xv[m][bj][n] = *(const f32x4*)(xin + (size_t)row * DM + u.pn * BM + bj * HALF + wc * 32 + 4 * n + 8 * fq); }
            __builtin_amdgcn_sched_barrier(0);
#pragma unroll
            for (int m = m0; m < m0 + 2; ++m) { const int row = u.pm * BM + ai * HALF + wr * 64 + m * 16 + fr;
#pragma unroll
                for (int bj = 0; bj < 2; ++bj)
#pragma unroll
                    for (int n = 0; n < 2; ++n) *(f32x4*)(xout + (size_t)row * DM + u.pn * BM + bj * HALF + wc * 32 + 4 * n + 8 * fq) = xv[m][bj][n] + gv[bj][n] * acc[ai][bj][m][n]; }
        }
    }
};
struct EpiUp {
    bf16_t* H;
    DI void operator()(const f32x4 (&acc)[2][2][4][2], const Unit& u, int wr, int wc, int fr, int fq) const {
        PG8_FOREACH({ f32x4 r; for (int e = 0; e < 4; ++e) { const float t = fmaxf(v[e], 0.f); r[e] = t * t; } u32x2 w; w.x = pk2(r[0], r[1]); w.y = pk2(r[2], r[3]); *(u32x2*)(H + (size_t)row * DFF + col) = w; })
    }
};
}

DI void p0_transpose_item(const float* W, int ldw, int col0, int K, bf16_t* WT, int row0, int nblk, LAS float* scr, int item, int lane) {
    const int kb = item / nblk, nb = item % nblk, k0 = 64 * kb, n0 = 32 * nb;
    float tv[32];
#pragma unroll
    for (int i = 0; i < 32; ++i) { const int kk = 2 * i + (lane >> 5); tv[i] = __builtin_nontemporal_load(&W[(size_t)(k0 + kk) * ldw + col0 + n0 + (lane & 31)]); }
#pragma unroll
    for (int i = 0; i < 32; ++i) { const int kk = 2 * i + (lane >> 5); scr[kk * 33 + (lane & 31)] = tv[i]; }
    asm volatile("s_waitcnt lgkmcnt(0)" ::: "memory");
    const int c = lane & 7;
#pragma unroll
    for (int j = 0; j < 4; ++j) { const int n = (lane >> 3) + 8 * j; const LAS float* s = scr + (8 * c) * 33 + n;
        u32x4 o; o.x = pk2(s[0 * 33], s[1 * 33]); o.y = pk2(s[2 * 33], s[3 * 33]); o.z = pk2(s[4 * 33], s[5 * 33]); o.w = pk2(s[6 * 33], s[7 * 33]);
        *(u32x4*)(WT + (size_t)(row0 + n0 + n) * K + k0 + 8 * c) = o; }
    asm volatile("s_waitcnt lgkmcnt(0)" ::: "memory");
}

DI void convert_weights(const Ctx& F, const Args& a, int l, int gw, int NGW) {
    unsigned char* ws = a.ws;
    LAS float* scr = (LAS float*)(F.lds + 16384 + F.wave * 12288);
    bf16_t* WB = (bf16_t*)(ws + WS_W);
    constexpr int I_IN0 = 16 * 64, I_IN1 = 16 * 48, I_IN2 = 16 * 32, I_G = 16 * 96, I_BR = 8 * 32, I_O = 16 * 32, I_UP = 16 * 128, I_DN = 64 * 32;
    constexpr int I_LAYER = I_IN0 + I_IN1 + I_IN2 + I_G + 3 * I_BR + I_O + I_UP + I_DN;
    bf16_t* wl = WB + (size_t)l * WO_LAYER;
    const float* win = a.in[5] + (size_t)l * DM * DIN;
    for (int it = gw; it < I_LAYER; it += NGW) {
        int r = it;
        if (r < I_IN0) { p0_transpose_item(win, DIN, 0, DM, wl + WO_IN, 0, 64, scr, r, F.lane); continue; } r -= I_IN0;
        if (r < I_IN1) { p0_transpose_item(win, DIN, 2056, DM, wl + WO_IN, 2048, 48, scr, r, F.lane); continue; } r -= I_IN1;
        if (r < I_IN2) { p0_transpose_item(win, DIN, 3600, DM, wl + WO_IN, 3584, 32, scr, r, F.lane); continue; } r -= I_IN2;
        if (r < I_G) { p0_transpose_item(win, DIN, 4624, DM, wl + WO_GATE, 0, 96, scr, r, F.lane); continue; } r -= I_G;
        if (r < 3 * I_BR) { const int rb = r / I_BR; p0_transpose_item(a.in[23] + (size_t)(l * 3 + rb) * 512 * DM, DM, 0, 512, wl + WO_BR + (size_t)rb * DM * 512, 0, 32, scr, r % I_BR, F.lane); continue; } r -= 3 * I_BR;
        if (r < I_O) { p0_transpose_item(a.in[24] + (size_t)l * DM * DM, DM, 0, DM, wl + WO_OUT, 0, 32, scr, r, F.lane); continue; } r -= I_O;
        if (r < I_UP) { p0_transpose_item(a.in[26] + (size_t)l * DM * DFF, DFF, 0, DM, wl + WO_UP, 0, 128, scr, r, F.lane); continue; } r -= I_UP;
        p0_transpose_item(a.in[27] + (size_t)l * DFF * DM, DM, 0, DFF, wl + WO_DOWN, 0, 32, scr, r, F.lane);
    }
}

DI void phase_p0(const Ctx& F, const Args& a) {
    unsigned char* ws = a.ws;
    float* MOD = (float*)(ws + WS_MOD);
    for (int it = F.bid; it < 192; it += F.G) {
        const int l = it / 96, cb = it % 96, col = cb * 64 + F.lane;
        const float* aw = a.in[2] + (size_t)l * DM * 6144; const float* cc = a.in[1];
        float s0 = 0.f, s1 = 0.f, s2 = 0.f, s3 = 0.f;
        for (int k0 = F.wave * 128; k0 < F.wave * 128 + 128; k0 += 16) {
            float wv[16];
#pragma unroll
            for (int j = 0; j < 16; ++j) wv[j] = __builtin_nontemporal_load(&aw[(size_t)(k0 + j) * 6144 + col]);
#pragma unroll
            for (int j = 0; j < 16; ++j) { const int k = k0 + j; s0 += silu_f(cc[k]) * wv[j]; s1 += silu_f(cc[DM + k]) * wv[j]; s2 += silu_f(cc[2 * DM + k]) * wv[j]; s3 += silu_f(cc[3 * DM + k]) * wv[j]; }
        }
        LAS float* red = (LAS float*)F.lds;
        red[(F.wave * 4 + 0) * 64 + F.lane] = s0; red[(F.wave * 4 + 1) * 64 + F.lane] = s1; red[(F.wave * 4 + 2) * 64 + F.lane] = s2; red[(F.wave * 4 + 3) * 64 + F.lane] = s3;
        __syncthreads();
        if (F.tid < 256) { const int b = F.tid >> 6, cl = F.tid & 63; float s = 0.f;
            for (int w = 0; w < 8; ++w) s += red[(w * 4 + b) * 64 + cl];
            MOD[(size_t)(l * 4 + b) * 6144 + cb * 64 + cl] = s + a.in[3][l * 6144 + cb * 64 + cl]; }
        __syncthreads();
    }
    float* WSM = (float*)(ws + WS_WSM);
    for (int e = F.bid * 512 + F.tid; e < 2 * 16 * 1024; e += F.G * 512) {
        const int l = e >> 14, j = (e >> 10) & 15, k = e & 1023; const int col = j < 8 ? 2048 + j : 3592 + (j - 8);
        WSM[e] = a.in[5][((size_t)l * DM + k) * DIN + col];
    }
    convert_weights(F, a, 0, F.bid * 8 + F.wave, F.G * 8);
}
template <bool SMALLC>
DI void phase_norm(const Ctx& F, const float* xsrc, const float* nw, const float* modl  , int sh_off, int sc_off, bf16_t* XN, const float* WSM, float* SMALL) {
    LAS float* wsm = (LAS float*)F.lds;
    if (SMALLC) { for (int e = F.tid; e < 16 * 1024 / 4; e += 512) ((LAS f32x4*)wsm)[e] = ((const f32x4*)WSM)[e]; __syncthreads(); }
    const int gw = F.bid * 8 + F.wave, NGW = F.G * 8, lane = F.lane;
    for (int blk = gw; blk < MTOK / 16; blk += NGW) {
        const int r0 = blk * 16, b = r0 >> 13;
        f32x4 Aj[4], Bj[4];
#pragma unroll
        for (int j = 0; j < 4; ++j) { const int col = 256 * j + 4 * lane; const f32x4 w = *(const f32x4*)(nw + col), sc = *(const f32x4*)(modl + b * 6144 + sc_off + col); Aj[j] = w * (sc + 1.0f); Bj[j] = *(const f32x4*)(modl + b * 6144 + sh_off + col); }
        f32x4 hv[2][4], nx[2][4];
#pragma unroll
        for (int p = 0; p < 2; ++p)
#pragma unroll
            for (int j = 0; j < 4; ++j) { nx[p][j] = __builtin_nontemporal_load((const f32x4*)(xsrc + (size_t)(r0 + p) * DM + 256 * j + 4 * lane)); }
        for (int rr = 0; rr < 16; rr += 2) {
#pragma unroll
            for (int p = 0; p < 2; ++p)
#pragma unroll
                for (int j = 0; j < 4; ++j) hv[p][j] = nx[p][j];
            if (rr + 2 < 16) {
#pragma unroll
                for (int p = 0; p < 2; ++p)
#pragma unroll
                    for (int j = 0; j < 4; ++j) nx[p][j] = __builtin_nontemporal_load((const f32x4*)(xsrc + (size_t)(r0 + rr + 2 + p) * DM + 256 * j + 4 * lane));
            }
            float ss0 = 0.f, ss1 = 0.f;
#pragma unroll
            for (int j = 0; j < 4; ++j) { ss0 += hv[0][j][0] * hv[0][j][0] + hv[0][j][1] * hv[0][j][1] + hv[0][j][2] * hv[0][j][2] + hv[0][j][3] * hv[0][j][3];
                                          ss1 += hv[1][j][0] * hv[1][j][0] + hv[1][j][1] * hv[1][j][1] + hv[1][j][2] * hv[1][j][2] + hv[1][j][3] * hv[1][j][3]; }
#pragma unroll
            for (int o = 1; o < 64; o <<= 1) { ss0 += __shfl_xor(ss0, o); ss1 += __shfl_xor(ss1, o); }
            const float rs0 = rsqrtf(ss0 * (1.f / DM) + 1e-6f), rs1 = rsqrtf(ss1 * (1.f / DM) + 1e-6f);
#pragma unroll
            for (int p = 0; p < 2; ++p) {
                bf16_t* orow = XN + (size_t)(r0 + rr + p) * DM; const float rstd = p == 0 ? rs0 : rs1;
#pragma unroll
                for (int j = 0; j < 4; ++j) { hv[p][j] = hv[p][j] * rstd * Aj[j] + Bj[j]; u32x2 w; w.x = pk2(hv[p][j][0], hv[p][j][1]); w.y = pk2(hv[p][j][2], hv[p][j][3]); *(u32x2*)(orow + 256 * j + 4 * lane) = w; }
            }
            if (SMALLC) {
                float v[32];
#pragma unroll
                for (int c = 0; c < 16; ++c) {
                    asm volatile("" ::: "memory");
                    float a0 = 0.f, a1 = 0.f;
#pragma unroll
                    for (int j = 0; j < 4; ++j) { const f32x4 w = *(const LAS f32x4*)(wsm + c * 1024 + 256 * j + 4 * lane);
                        a0 += hv[0][j][0] * w[0] + hv[0][j][1] * w[1] + hv[0][j][2] * w[2] + hv[0][j][3] * w[3];
                        a1 += hv[1][j][0] * w[0] + hv[1][j][1] * w[1] + hv[1][j][2] * w[2] + hv[1][j][3] * w[3]; }
                    v[c] = a0; v[16 + c] = a1;
                }
#define RS_STEP(N, MASK) do { const bool up_ = (lane & (MASK)) != 0; _Pragma("unroll") for (int k_ = 0; k_ < (N) / 2; ++k_) { const float send_ = up_ ? v[k_] : v[k_ + (N) / 2]; const float keep_ = up_ ? v[k_ + (N) / 2] : v[k_]; v[k_] = keep_ + __shfl_xor(send_, (MASK)); } } while (0)
                RS_STEP(32, 1); RS_STEP(16, 2); RS_STEP(8, 4); RS_STEP(4, 8); RS_STEP(2, 16);
#undef RS_STEP
                const float tot = v[0] + __shfl_xor(v[0], 32);
                if (lane < 32) { const int p = lane & 1, c = 8 * ((lane >> 1) & 1) + 4 * ((lane >> 2) & 1) + 2 * ((lane >> 3) & 1) + ((lane >> 4) & 1); SMALL[(size_t)(r0 + rr + p) * 16 + c] = tot; }
            }
        }
    }
}
DI void phase_final_norm(const Ctx& F, float* x, const float* nw) {
    const int gw = F.bid * 8 + F.wave, NGW = F.G * 8, lane = F.lane;
    for (int r = gw; r < MTOK; r += NGW) {
        float* xr = x + (size_t)r * DM; f32x4 v[4]; float ss = 0.f;
#pragma unroll
        for (int j = 0; j < 4; ++j) { v[j] = __builtin_nontemporal_load((const f32x4*)(xr + 256 * j + 4 * lane)); ss += v[j][0] * v[j][0] + v[j][1] * v[j][1] + v[j][2] * v[j][2] + v[j][3] * v[j][3]; }
        const float rstd = rsqrtf(wave_sum(ss) * (1.f / DM) + 1e-6f);
#pragma unroll
        for (int j = 0; j < 4; ++j) __builtin_nontemporal_store(v[j] * rstd * *(const f32x4*)(nw + 256 * j + 4 * lane), (f32x4*)(xr + 256 * j + 4 * lane));
    }
}

constexpr size_t WS_BAR = 512 * 1024;
#define XB_TMO      128
#define XB_XCNT(j)  (256  + 64 * (j))
#define XB_XSUB(j)  (1280 + 64 * (j))
#define XB_XGEN(j)  (2304 + 64 * (j))
#define XB_TOP      3328
#define XB_TOPGEN   3392
#define XCD_BAR_WORDS 3456
#define XB_SPIN_CAP (1u << 22)
DI unsigned xb_ld(unsigned* p)              { return __hip_atomic_load(p, __ATOMIC_RELAXED, __HIP_MEMORY_SCOPE_AGENT); }
DI unsigned xb_add(unsigned* p, unsigned v) { return __hip_atomic_fetch_add(p, v, __ATOMIC_RELAXED, __HIP_MEMORY_SCOPE_AGENT); }
DI unsigned xb_xcc_id() { return (unsigned)__builtin_amdgcn_s_getreg((3 << 11) | 20) & 0xFu; }
#define XB_SPIN(cond, bar) do { unsigned _sp = 0; while (cond) { __builtin_amdgcn_s_sleep(1); \
    if ((++_sp & 255u) == 0u) { if (xb_ld(&(bar)[XB_TMO])) break; if (_sp > XB_SPIN_CAP) { atomicAdd(&(bar)[XB_TMO], 1u); break; } } } } while (0)
struct XcdBarrier { unsigned* bar; unsigned x; volatile LAS unsigned* st; };
DI XcdBarrier xcd_barrier_post(unsigned* bar, volatile LAS unsigned* st) {
    XcdBarrier b; b.bar = bar; b.x = xb_xcc_id(); b.st = st;
    if (threadIdx.x == 0) (void)xb_add(&bar[XB_XCNT(b.x)], 1u);
    return b;
}
DI void xcd_barrier_complete(unsigned* bar, unsigned x, unsigned& nloc, unsigned& nx) {
    const unsigned G = gridDim.x * gridDim.y * gridDim.z;
    unsigned sum, cnt, mine, sp = 0u;
    for (;;) {
        sum = 0u; cnt = 0u; mine = 0u;
#pragma unroll
        for (unsigned j = 0; j < 16; ++j) { const unsigned c = xb_ld(&bar[XB_XCNT(j)]); sum += c; cnt += (c > 0u) ? 1u : 0u; mine = (j == x) ? c : mine; }
        if (sum == G) break;
        __builtin_amdgcn_s_sleep(1);
        if ((++sp & 255u) == 0u) { if (xb_ld(&bar[XB_TMO])) break; if (sp > XB_SPIN_CAP) { atomicAdd(&bar[XB_TMO], 1u); break; } }
    }
    nloc = mine > 0u ? mine : 1u; nx = cnt > 0u ? cnt : 1u;
}
DI void xcd_barrier(const XcdBarrier& b) {
    asm volatile("s_waitcnt vmcnt(0)" ::: "memory");
    __syncthreads();
    if (threadIdx.x == 0) {
        unsigned* bar = b.bar;
        __builtin_amdgcn_s_waitcnt(0);
        unsigned nloc = b.st[0], nx = b.st[1];
        if (nloc == 0u) { xcd_barrier_complete(bar, b.x, nloc, nx); b.st[0] = nloc; b.st[1] = nx; }
        const unsigned old = xb_add(&bar[XB_XSUB(b.x)], 1u);
        const unsigned gen = old / nloc;
        if (old + 1u == (gen + 1u) * nloc) {
            __builtin_amdgcn_fence(__ATOMIC_RELEASE, "agent");
            asm volatile("s_waitcnt vmcnt(0)" ::: "memory");
            const unsigned og = xb_add(&bar[XB_TOP], 1u);
            const unsigned tg = og / nx;
            if (og + 1u == (tg + 1u) * nx) xb_add(&bar[XB_TOPGEN], 1u);
            else XB_SPIN(xb_ld(&bar[XB_TOPGEN]) == tg, bar);
            __builtin_amdgcn_fence(__ATOMIC_ACQUIRE, "agent");
            xb_add(&bar[XB_XGEN(b.x)], 1u);
            asm volatile("s_waitcnt vmcnt(0)" ::: "memory");
        } else {
            XB_SPIN(xb_ld(&bar[XB_XGEN(b.x)]) == gen, bar);
            __builtin_amdgcn_fence(__ATOMIC_ACQUIRE, "agent");
            asm volatile("s_waitcnt vmcnt(0)" ::: "memory");
        }
    }
    __syncthreads();
}

DI void gdn_prep_unit(const Ctx& F, const Args& a, int l, int unit) {
    const int h = unit & 3, c = (unit >> 2) & 127, b = unit >> 9;
    const int row0 = b * SEQ + c * 64, w = F.wave, lane = F.lane;
    bf16_t* PROJ = (bf16_t*)(a.ws + WS_PROJ);
    const bf16_t* TAIL = (const bf16_t*)(a.ws + WS_TAIL);
    LAS bf16_t* Qs = (LAS bf16_t*)(F.lds);
    LAS bf16_t* Ks = (LAS bf16_t*)(F.lds + 17408);
    LAS bf16_t* KTs = (LAS bf16_t*)(F.lds + 34816);
    LAS bf16_t* VTs = (LAS bf16_t*)(F.lds + 53248);
    LAS float* Ms = (LAS float*)(F.lds + 71680);
    LAS bf16_t* T1s = (LAS bf16_t*)(F.lds + 89088);
    LAS bf16_t* T2s = (LAS bf16_t*)(F.lds + 98304);
    LAS float* beta_s = (LAS float*)(F.lds + 107520);
    LAS float* gcum_s = (LAS float*)(F.lds + 107776);
    if (w < 6) {
        const int part = w % 3, rq = w / 3, r0 = rq * 32;
        const int col = part * 512 + h * 128 + 2 * lane;
        const float* cw = a.in[6] + (size_t)l * 4 * 1536 + col;
        float w0[4], w1[4];
#pragma unroll
        for (int k = 0; k < 4; ++k) { w0[k] = cw[k * 1536]; w1[k] = cw[k * 1536 + 1]; }
        float p0[3], p1[3];
#pragma unroll
        for (int i = 0; i < 3; ++i) {
            unsigned v = 0u;
            if (rq == 0) { if (c > 0) v = *(const unsigned*)(TAIL + ((size_t)(b * 128 + c - 1) * 3 + i) * 1536 + col); }
            else v = *(const unsigned*)(PROJ + (size_t)(row0 + 29 + i) * NPROJ + col);
            p0[i] = bflo(v); p1[i] = bfhi(v);
        }
        float va[32], vb[32];
#pragma unroll
        for (int i = 0; i < 32; ++i) {
            const unsigned v = *(const unsigned*)(PROJ + (size_t)(row0 + r0 + i) * NPROJ + col);
            const float x0 = bflo(v), x1 = bfhi(v);
            const float y0 = w0[0] * p0[0] + w0[1] * p0[1] + w0[2] * p0[2] + w0[3] * x0;
            const float y1 = w1[0] * p1[0] + w1[1] * p1[1] + w1[2] * p1[2] + w1[3] * x1;
            p0[0] = p0[1]; p0[1] = p0[2]; p0[2] = x0; p1[0] = p1[1]; p1[1] = p1[2]; p1[2] = x1;
            va[i] = silu_f(y0); vb[i] = silu_f(y1);
        }
        if (part < 2) {
            const float extra = part == 0 ? 0.08838834764831845f : 1.0f;
            float v[32];
#pragma unroll
            for (int i = 0; i < 32; ++i) v[i] = va[i] * va[i] + vb[i] * vb[i];
#define RS_STEP(N, MASK) do { const bool up_ = (lane & (MASK)) != 0; _Pragma("unroll") for (int k_ = 0; k_ < (N) / 2; ++k_) { const float send_ = up_ ? v[k_] : v[k_ + (N) / 2]; const float keep_ = up_ ? v[k_ + (N) / 2] : v[k_]; v[k_] = keep_ + __shfl_xor(send_, (MASK)); } } while (0)
            RS_STEP(32, 1); RS_STEP(16, 2); RS_STEP(8, 4); RS_STEP(4, 8); RS_STEP(2, 16);
#undef RS_STEP
            const float tot = v[0] + __shfl_xor(v[0], 32);
#pragma unroll
            for (int i = 0; i < 32; ++i) {
                constexpr int dummy = 0; (void)dummy;
                const int src = ((i >> 4) & 1) | (((i >> 3) & 1) << 1) | (((i >> 2) & 1) << 2) | (((i >> 1) & 1) << 3) | ((i & 1) << 4);
                const float ss = __builtin_bit_cast(float, __builtin_amdgcn_readlane(__builtin_bit_cast(int, tot), src));
                const float sc = rsqrtf(ss + 1e-6f) * extra; va[i] *= sc; vb[i] *= sc;
            }
        }
        if (part == 0) {
#pragma unroll
            for (int i = 0; i < 32; ++i) *(LAS unsigned*)(Qs + (r0 + i) * 136 + 2 * lane) = pk2(va[i], vb[i]);
        } else {
            LAS bf16_t* T = part == 1 ? KTs : VTs;
            if (part == 1) {
#pragma unroll
                for (int i = 0; i < 32; ++i) *(LAS unsigned*)(Ks + (r0 + i) * 136 + 2 * lane) = pk2(va[i], vb[i]);
            }
#pragma unroll
            for (int i = 0; i < 32; i += 8) {
                *(LAS u32x4*)(T + (2 * lane) * 72 + r0 + i) = (u32x4){pk2(va[i], va[i + 1]), pk2(va[i + 2], va[i + 3]), pk2(va[i + 4], va[i + 5]), pk2(va[i + 6], va[i + 7])};
                *(LAS u32x4*)(T + (2 * lane + 1) * 72 + r0 + i) = (u32x4){pk2(vb[i], vb[i + 1]), pk2(vb[i + 2], vb[i + 3]), pk2(vb[i + 4], vb[i + 5]), pk2(vb[i + 6], vb[i + 7])}; }
        }
    } else if (w == 6) {
        const float* sm = (const float*)(a.ws + WS_SMALL) + (size_t)(row0 + lane) * 16;
        const float braw = sm[h], araw = sm[4 + h];
        const float g = -__expf(a.in[7][l * 4 + h]) * softplus_f(araw + a.in[8][l * 4 + h]);
        const float gc = wave_incl_scan(g, lane);
        beta_s[lane] = sigmoid_f(braw); gcum_s[lane] = gc;
        ((float*)(a.ws + WS_GC))[((size_t)(b * 4 + h) * 128 + c) * 64 + lane] = __expf(gc);
    }
    GDN_BAR();
    {
        const int mat = w >> 2, ci = w & 3, fr = lane & 15, q = lane >> 4;
        const LAS bf16_t* Xs = mat == 0 ? Ks : Qs;
        const int cc = 16 * ci + fr; const float gcc = gcum_s[cc], bcc = beta_s[cc];
        bf16_t* QKg = (bf16_t*)(a.ws + WS_QK) + (size_t)unit * 4096;
#pragma unroll
        for (int ej = 0; ej < 4; ++ej) {
            f32x4 acc = {0.f, 0.f, 0.f, 0.f};
#pragma unroll
            for (int s = 0; s < 4; ++s) acc = MFMA16(ldfrag(Ks, 136, 16 * ej + fr, 32 * s + 8 * q), ldfrag(Xs, 136, cc, 32 * s + 8 * q), acc);
            const int e0 = 16 * ej + 4 * q; f32x4 o;
#pragma unroll
            for (int r = 0; r < 4; ++r) { const int e = e0 + r; const float dec = __expf(gcc - gcum_s[e]);
                if (mat == 0) o[r] = (e < cc) ? bcc * acc[r] * dec : 0.f; else o[r] = (e <= cc) ? acc[r] * dec : 0.f; }
            if (mat == 0) *(LAS f32x4*)(Ms + cc * 68 + e0) = o;
            else { u32x2 wv; wv.x = pk2(o[0], o[1]); wv.y = pk2(o[2], o[3]); *(u32x2*)(QKg + cc * 64 + 16 * ej + 4 * (((q & 1) << 1) | (q >> 1))) = wv; }
        }
    }
    GDN_BAR();
    if (w == 0) {
        float t[64]; const float flane = (float)lane;
        LAS unsigned char* msb = (LAS unsigned char*)Ms; asm volatile("" : "+v"(msb));
        f32x4 mc[16], mn[16];
#pragma unroll
        for (int v = 0; v < 16; ++v) { mc[v] = (f32x4){0.f, 0.f, 0.f, 0.f}; mn[v] = mc[v]; }
        t[0] = fmaxf(0.f, 1.f - fabsf(flane));
        mc[0] = *(const LAS f32x4*)(msb + (1 * 68) * 4);
#pragma clang loop unroll(full)
        for (int i = 1; i < 64; ++i) {
            if (i + 1 < 64) {
#pragma unroll
                for (int v = 0; v < 16; ++v) if (4 * v < i + 1) mn[v] = *(const LAS f32x4*)(msb + ((i + 1) * 68 + 4 * v) * 4);
            }
            __builtin_amdgcn_sched_barrier(0);
            float s0 = fmaxf(0.f, 1.f - fabsf(flane - (float)i)), s1 = 0.f, s2 = 0.f, s3 = 0.f;
#pragma unroll
            for (int v = 0; v < 16; ++v) {
                if (4 * v < i) s0 -= mc[v][0] * t[4 * v];
                if (4 * v + 1 < i) s1 -= mc[v][1] * t[4 * v + 1];
                if (4 * v + 2 < i) s2 -= mc[v][2] * t[4 * v + 2];
                if (4 * v + 3 < i) s3 -= mc[v][3] * t[4 * v + 3];
            }
            t[i] = (s0 + s1) + (s2 + s3);
#pragma unroll
            for (int v = 0; v < 16; ++v) mc[v] = mn[v];
            __builtin_amdgcn_sched_barrier(0);
        }
        const float b1 = beta_s[lane], b2 = b1 * __expf(gcum_s[lane]);
#pragma unroll
        for (int i = 0; i < 64; ++i) { T1s[i * 72 + lane] = (bf16_t)f2bf(t[i] * b1); T2s[i * 72 + lane] = (bf16_t)f2bf(t[i] * b2); }
    } else {
        const int t = F.tid - 64; const float glast = gcum_s[63];
        bf16_t* KDTg = (bf16_t*)(a.ws + WS_KDT) + (size_t)unit * 8192;
        for (int v = t; v < 1024; v += 448) {
            const int dk = v >> 3, c8 = (v & 7) * 8;
            const u32x4 kv = *(const LAS u32x4*)(KTs + dk * 72 + c8); float sc[8];
#pragma unroll
            for (int j = 0; j < 8; ++j) sc[j] = __expf(glast - gcum_s[c8 + j]);
            u32x4 o; o.x = pk2(bflo(kv.x) * sc[0], bfhi(kv.x) * sc[1]); o.y = pk2(bflo(kv.y) * sc[2], bfhi(kv.y) * sc[3]); o.z = pk2(bflo(kv.z) * sc[4], bfhi(kv.z) * sc[5]); o.w = pk2(bflo(kv.w) * sc[6], bfhi(kv.w) * sc[7]);
            { const int b16 = c8 & ~15, hf = (c8 >> 3) & 1; *(u32x2*)(KDTg + dk * 64 + b16 + 4 * hf) = (u32x2){o.x, o.y}; *(u32x2*)(KDTg + dk * 64 + b16 + 8 + 4 * hf) = (u32x2){o.z, o.w}; }
        }
        for (int v = t; v < 1024; v += 448) {
            const int row = v >> 4, k8 = (v & 15) * 8;
            { const u32x4 qv = *(const LAS u32x4*)(Qs + row * 136 + k8); const int b16 = k8 & ~15, hf = (k8 >> 3) & 1; bf16_t* qp = PROJ + (size_t)(row0 + row) * NPROJ + PC_Q + h * 128 + b16;
              *(u32x2*)(qp + 4 * hf) = (u32x2){qv.x, qv.y}; *(u32x2*)(qp + 8 + 4 * hf) = (u32x2){qv.z, qv.w}; }
        }
    }
    GDN_BAR();
    {
        const int fr = lane & 15, q = lane >> 4;
#pragma unroll
        for (int ci = 0; ci < 4; ++ci) {
            f32x4 acc = {0.f, 0.f, 0.f, 0.f};
#pragma unroll
            for (int s = 0; s < 2; ++s) acc = MFMA16(ldfrag(KTs, 72, 16 * w + fr, 32 * s + 8 * q), ldfrag(T2s, 72, 16 * ci + fr, 32 * s + 8 * q), acc);
            u32x2 wv; wv.x = pk2(acc[0], acc[1]); wv.y = pk2(acc[2], acc[3]);
            *(u32x2*)(PROJ + (size_t)(row0 + 16 * ci + fr) * NPROJ + PC_K + h * 128 + 16 * w + 4 * (((q & 1) << 1) | (q >> 1))) = wv;
            f32x4 au = {0.f, 0.f, 0.f, 0.f};
#pragma unroll
            for (int s = 0; s < 2; ++s) au = MFMA16(ldfrag(T1s, 72, 16 * ci + fr, 32 * s + 8 * q), ldfrag(VTs, 72, 16 * w + fr, 32 * s + 8 * q), au);
            const int L = (w >> 1) * 64 + (q & 1) * 32 + 16 * (w & 1) + fr, pos = (ci >> 1) * 16 + 4 * (2 * (ci & 1) + (q >> 1));
            u32x2 uv; uv.x = pk2(au[0], au[1]); uv.y = pk2(au[2], au[3]);
            *(u32x2*)(PROJ + (size_t)(row0 + (L >> 2)) * NPROJ + PC_V + h * 128 + (L & 3) * 32 + pos) = uv;
        }
    }
    GDN_BAR();
}

DI void gdn_cons_iter(LAS unsigned char* lds, int c, int climit, f32x16 (&S)[4], u32x4 (&UC)[4], const bf16_t* urec, int n, int hh, int dv0) {
    constexpr int BUFB = 62464, OFF_Q = 17408, OFF_QK = 34816, OFF_KD = 44032, OFF_GC = 2 * BUFB, OFF_OS = OFF_GC + 512;
    const LAS bf16_t* Wl = (const LAS bf16_t*)(lds + (c & 1) * BUFB);
    const LAS bf16_t* Ql = (const LAS bf16_t*)(lds + (c & 1) * BUFB + OFF_Q);
    const LAS bf16_t* QKl = (const LAS bf16_t*)(lds + (c & 1) * BUFB + OFF_QK);
    const LAS bf16_t* KDl = (const LAS bf16_t*)(lds + (c & 1) * BUFB + OFF_KD);
    const LAS float* gc = (const LAS float*)(lds + OFF_GC) + (c & 1) * 64;
    LAS bf16_t* Og = (LAS bf16_t*)(lds + OFF_OS) + (c & 1) * (64 * 136) + dv0 + n;
    bf16x8 f0[4], f1[4], f2[4];
#define LD4(dst, base, pitch, row, kofs) do { _Pragma("unroll") for (int k_ = 0; k_ < 4; ++k_) dst[k_] = ldfrag(base, pitch, (row), (kofs) + 16 * k_ + 8 * hh); } while (0)
#define MM4(acc, fr, bb, bo) do { _Pragma("unroll") for (int k_ = 0; k_ < 4; ++k_) acc = MFMA32(fr[k_], bb[(bo) + k_], acc); } while (0)
    LD4(f0, Wl, 136, n, 0); LD4(f1, Wl, 136, n, 64); LD4(f2, Wl, 136, 32 + n, 0);
    bf16x8 Sb[8];
#pragma unroll
    for (int k = 0; k < 8; ++k) { const int t = k >> 1, s8 = 8 * (k & 1); Sb[k] = pack8(S[t][s8], S[t][s8 + 1], S[t][s8 + 2], S[t][s8 + 3], S[t][s8 + 4], S[t][s8 + 5], S[t][s8 + 6], S[t][s8 + 7]); }
    const float gt = gc[63];
    SCHEDB();
    f32x16 WS0, WS1;
#pragma unroll
    for (int r = 0; r < 16; ++r) { WS0[r] = 0.f; WS1[r] = 0.f; }
    MM4(WS0, f0, Sb, 0); SCHEDB(); LD4(f0, Wl, 136, 32 + n, 64); SCHEDB();
    MM4(WS0, f1, Sb, 4); SCHEDB(); LD4(f1, Ql, 136, n, 0); SCHEDB();
    MM4(WS1, f2, Sb, 0); SCHEDB(); LD4(f2, Ql, 136, n, 64); SCHEDB();
    MM4(WS1, f0, Sb, 4); SCHEDB();
    f0[0] = ldfrag(QKl, 72, n, 8 * hh); f0[1] = ldfrag(QKl, 72, n, 16 + 8 * hh); SCHEDB();
    bf16x8 Vb[4];
    {
        float vn[16];
#pragma unroll
        for (int r = 0; r < 16; ++r) { const unsigned uw = UC[r >> 3][(r >> 1) & 3]; vn[r] = ((r & 1) ? bfhi(uw) : bflo(uw)) - WS0[r]; }
        Vb[0] = pack8(vn[0], vn[1], vn[2], vn[3], vn[4], vn[5], vn[6], vn[7]); Vb[1] = pack8(vn[8], vn[9], vn[10], vn[11], vn[12], vn[13], vn[14], vn[15]);
#pragma unroll
        for (int r = 0; r < 16; ++r) { const unsigned uw = UC[2 + (r >> 3)][(r >> 1) & 3]; vn[r] = ((r & 1) ? bfhi(uw) : bflo(uw)) - WS1[r]; }
        Vb[2] = pack8(vn[0], vn[1], vn[2], vn[3], vn[4], vn[5], vn[6], vn[7]); Vb[3] = pack8(vn[8], vn[9], vn[10], vn[11], vn[12], vn[13], vn[14], vn[15]);
    }
    if (c + 1 < climit) { const bf16_t* un = urec + (size_t)(c + 1) * 64 * NPROJ;
#pragma unroll
        for (int j = 0; j < 4; ++j) UC[j] = *(const u32x4*)(un + 8 * j); }
    SCHEDB();
    {
        f32x16 O;
#pragma unroll
        for (int r = 0; r < 16; ++r) O[r] = 0.f;
        MM4(O, f1, Sb, 0); SCHEDB(); LD4(f1, Ql, 136, 32 + n, 0); SCHEDB();
        MM4(O, f2, Sb, 4); SCHEDB(); LD4(f2, Ql, 136, 32 + n, 64); SCHEDB();
#pragma unroll
        for (int r = 0; r < 16; ++r) O[r] *= gc[crow(r, hh)];
        O = MFMA32(f0[0], Vb[0], O); O = MFMA32(f0[1], Vb[1], O);
        SCHEDB(); LD4(f0, QKl, 72, 32 + n, 0); SCHEDB();
#pragma unroll
        for (int r = 0; r < 16; ++r) Og[crow(r, hh) * 136] = (bf16_t)f2bf(O[r]);
    }
    SCHEDB();
    {
        f32x16 O;
#pragma unroll
        for (int r = 0; r < 16; ++r) O[r] = 0.f;
        MM4(O, f1, Sb, 0); SCHEDB(); LD4(f1, KDl, 72, n, 0); SCHEDB();
        MM4(O, f2, Sb, 4); SCHEDB(); LD4(f2, KDl, 72, 32 + n, 0); SCHEDB();
#pragma unroll
        for (int r = 0; r < 16; ++r) O[r] *= gc[32 + crow(r, hh)];
        MM4(O, f0, Vb, 0); SCHEDB(); LD4(f0, KDl, 72, 64 + n, 0); SCHEDB();
#pragma unroll
        for (int r = 0; r < 16; ++r) Og[(32 + crow(r, hh)) * 136] = (bf16_t)f2bf(O[r]);
    }
    SCHEDB();
#pragma unroll
    for (int t = 0; t < 4; ++t)
#pragma unroll
        for (int r = 0; r < 16; ++r) S[t][r] *= gt;
    MM4(S[0], f1, Vb, 0); SCHEDB(); LD4(f1, KDl, 72, 96 + n, 0); SCHEDB();
    MM4(S[1], f2, Vb, 0); SCHEDB();
    MM4(S[2], f0, Vb, 0); SCHEDB();
    MM4(S[3], f1, Vb, 0);
    GDN_BAR();
#undef MM4
#undef LD4
}
DI void gdn_seq(const Ctx& F, const Args& a, int l, int bh, const XcdBarrier& xbar) {
    const int b = bh >> 2, h = bh & 3, w = F.wave, lane = F.lane, n = lane & 31, hh = lane >> 5;
    bf16_t* PROJ = (bf16_t*)(a.ws + WS_PROJ);
    const bf16_t* QKa = (const bf16_t*)(a.ws + WS_QK);
    const bf16_t* KDTa = (const bf16_t*)(a.ws + WS_KDT);
    const float* GC = (const float*)(a.ws + WS_GC) + (size_t)bh * 128 * 64;
    constexpr int BUFB = 62464, OFF_Q = 17408, OFF_QK = 34816, OFF_KD = 44032, OFF_GC = 2 * BUFB, OFF_OS = OFF_GC + 512;
    LAS float* gcs = (LAS float*)(F.lds + OFF_GC);
    LAS float* Os = (LAS float*)(F.lds + OFF_OS);
    const int rowb = b * SEQ;
    if (w < 4) {
        const int dv0 = 32 * w;
        f32x16 S[4];
#pragma unroll
        for (int t = 0; t < 4; ++t)
#pragma unroll
            for (int i = 0; i < 16; ++i) S[t][i] = 0.f;
        const int L = w * 64 + lane;
        const bf16_t* urec = PROJ + (size_t)(rowb + (L >> 2)) * NPROJ + PC_V + h * 128 + (L & 3) * 32;
        u32x4 uA[4];
        for (int half = 0; half < 2; ++half) {
            const int c0 = 64 * half;
            if (half == 1) xcd_barrier(xbar);
#pragma unroll
            for (int j = 0; j < 4; ++j) uA[j] = *(const u32x4*)(urec + (size_t)c0 * 64 * NPROJ + 8 * j);
            GDN_BAR();
            for (int c = c0; c < c0 + 64; ++c) gdn_cons_iter(F.lds, c, c0 + 64, S, uA, urec, n, hh, dv0);
            GDN_BAR();
        }
    } else {
        const int lt = F.tid - 256, nrow = lt >> 2, nseg = lt & 3;
        u32x4 preA[14]; f32x4 pgA = {0.f, 0.f, 0.f, 0.f};
        const unsigned offWQ = (unsigned)(((lt >> 4) * NPROJ + (lt & 15) * 8) * 2), offLin = (unsigned)(lt * 16), offZ = (unsigned)((nrow * NPROJ + nseg * 32) * 2);
#define GDN_LDG(base, off) (*(const u32x4*)((const char*)(base) + (off)))
#define GDN_ISSUE(pre, pg, cc) do { const bf16_t* wb_ = PROJ + (size_t)(rowb + (cc) * 64) * NPROJ + PC_K + h * 128; const bf16_t* qb_ = PROJ + (size_t)(rowb + (cc) * 64) * NPROJ + PC_Q + h * 128; \
            const bf16_t* kd_ = KDTa + (size_t)((b * 128 + (cc)) * 4 + h) * 8192; const bf16_t* qk_ = QKa + (size_t)((b * 128 + (cc)) * 4 + h) * 4096; \
            _Pragma("unroll") for (int j = 0; j < 4; ++j) { pre[j] = GDN_LDG(wb_, offWQ + (unsigned)(16 * j * NPROJ * 2)); pre[4 + j] = GDN_LDG(qb_, offWQ + (unsigned)(16 * j * NPROJ * 2)); pre[10 + j] = GDN_LDG(kd_, offLin + 4096u * j); } \
            _Pragma("unroll") for (int j = 0; j < 2; ++j) pre[8 + j] = GDN_LDG(qk_, offLin + 4096u * j); \
            if (lt < 16) pg = *(const f32x4*)(GC + (cc) * 64 + lt * 4); } while (0)
#define GDN_WRITE(pre, pg, cc) do { LAS unsigned char* bb = F.lds + ((cc) & 1) * BUFB; \
            _Pragma("unroll") for (int j = 0; j < 4; ++j) { const int id = lt + 256 * j; *(LAS u32x4*)(bb + (id >> 4) * 272 + (id & 15) * 16) = pre[j]; \
                *(LAS u32x4*)(bb + OFF_Q + (id >> 4) * 272 + (id & 15) * 16) = pre[4 + j]; \
                *(LAS u32x4*)(bb + OFF_KD + (id >> 3) * 144 + (id & 7) * 16) = pre[10 + j]; } \
            _Pragma("unroll") for (int j = 0; j < 2; ++j) { const int id = lt + 256 * j; *(LAS u32x4*)(bb + OFF_QK + (id >> 3) * 144 + (id & 7) * 16) = pre[8 + j]; } \
            if (lt < 16) *(LAS f32x4*)(gcs + ((cc) & 1) * 64 + lt * 4) = pg; } while (0)
        for (int half = 0; half < 2; ++half) {
        const int c0 = 64 * half, c1 = c0 + 64;
        if (half == 1) xcd_barrier(xbar);
        GDN_ISSUE(preA, pgA, c0); GDN_WRITE(preA, pgA, c0); GDN_ISSUE(preA, pgA, c0 + 1);
        GDN_BAR();
#define GDN_COPY_O(cc) do { const LAS unsigned char* os_ = F.lds + OFF_OS + ((cc) & 1) * (64 * 136 * 2) + nrow * 272 + nseg * 64; \
            bf16_t* og_ = (bf16_t*)(a.ws + WS_KDT) + (size_t)((b * 128 + (cc)) * 4 + h) * 8192 + nrow * 128 + nseg * 32; \
            _Pragma("unroll") for (int j = 0; j < 4; ++j) *(u32x4*)(og_ + 8 * j) = *(const LAS u32x4*)(os_ + 16 * j); } while (0)
        for (int c = c0; c < c1; ++c) {
            if (c + 1 < c1) { GDN_WRITE(preA, pgA, c + 1); if (c + 2 < c1) GDN_ISSUE(preA, pgA, c + 2); }
            if (c > c0) GDN_COPY_O(c - 1);
            GDN_BAR();
        }
        GDN_COPY_O(c1 - 1);
        GDN_BAR();
        }
#undef GDN_COPY_O
#undef GDN_ISSUE
#undef GDN_WRITE
#undef GDN_READ_OS
#undef GDN_NORM_STORE
    }
}

DI void gdn_post(const Ctx& F, const Args& a, int l) {
    bf16_t* PROJ = (bf16_t*)(a.ws + WS_PROJ);
    const bf16_t* OG = (const bf16_t*)(a.ws + WS_KDT);
    const int sub = F.lane >> 4, l16 = F.lane & 15;
    const float* nwp = a.in[9] + l * 128 + l16 * 8;
    float nw[8];
#pragma unroll
    for (int j = 0; j < 8; ++j) nw[j] = nwp[j];
    for (int it = (F.bid * 8 + F.wave) * 4 + sub; it < MTOK * 4; it += F.G * 32) {
        const int row = it >> 2, h = it & 3, b = row >> 13, c = (row >> 6) & 127, rr = row & 63;
        const u32x4 ov = *(const u32x4*)(OG + (size_t)((b * 128 + c) * 4 + h) * 8192 + rr * 128 + l16 * 8);
        bf16_t* zp = PROJ + (size_t)row * NPROJ + PC_GZ + h * 128 + l16 * 8;
        const u32x4 zv = *(const u32x4*)zp;
        const unsigned oo[4] = {ov.x, ov.y, ov.z, ov.w}, zz[4] = {zv.x, zv.y, zv.z, zv.w};
        float ss = 0.f;
#pragma unroll
        for (int e = 0; e < 4; ++e) { const float a0 = bflo(oo[e]), a1 = bfhi(oo[e]); ss += a0 * a0 + a1 * a1; }
        ss += __shfl_xor(ss, 1); ss += __shfl_xor(ss, 2); ss += __shfl_xor(ss, 4); ss += __shfl_xor(ss, 8);
        const float rstd = rsqrtf(ss * (1.f / 128.f) + 1e-6f);
        unsigned yy[4];
#pragma unroll
        for (int e = 0; e < 4; ++e) yy[e] = pk2(bflo(oo[e]) * rstd * nw[2 * e] * silu_f(bflo(zz[e])), bfhi(oo[e]) * rstd * nw[2 * e + 1] * silu_f(bfhi(zz[e])));
        *(u32x4*)zp = (u32x4){yy[0], yy[1], yy[2], yy[3]};
    }
}

DI void ssd_pass_a(const Ctx& F, const Args& a, int l, int unit) {
    const int h = unit & 7, seg = (unit >> 3) & 15, b = unit >> 7, g = h >> 2;
    const int w = F.wave, lane = F.lane, tid = F.tid, fr = lane & 15, q = lane >> 4;
    const bf16_t* PROJ = (const bf16_t*)(a.ws + WS_PROJ);
    LAS bf16_t* XTs = (LAS bf16_t*)F.lds;
    LAS bf16_t* BTs = (LAS bf16_t*)(F.lds + 9216);
    LAS float* dt_s = (LAS float*)(F.lds + 27648);
    LAS float* ac_s = (LAS float*)(F.lds + 27904);
    f32x4 ST[4];
#pragma unroll
    for (int j = 0; j < 4; ++j) ST[j] = (f32x4){0.f, 0.f, 0.f, 0.f};
    const bool cact = tid < 384; const int cp = tid % 96, kq = tid / 96, col2 = 2 * cp; const bool isx = col2 < 64;
    const int pcol = isx ? PC_SX + h * 64 + col2 : PC_BM + g * 128 + (col2 - 64);
    const int cch = isx ? h * 64 + col2 : 512 + g * 128 + (col2 - 64);
    float cw0[4], cw1[4];
#pragma unroll
    for (int k = 0; k < 4; ++k) { cw0[k] = a.in[10][(size_t)(l * 4 + k) * 1024 + cch]; cw1[k] = a.in[10][(size_t)(l * 4 + k) * 1024 + cch + 1]; }
    const float cb0 = a.in[11][l * 1024 + cch], cb1 = a.in[11][l * 1024 + cch + 1];
    const int rseg = b * SEQ + seg * 512;
    const float dtb = a.in[13][l * 8 + h], negA = -__expf(a.in[12][l * 8 + h]);
    float ltot = 0.f;
    unsigned raw[19], rawn[19]; float dtr = 0.f, dtrn = 0.f;
#pragma unroll
    for (int i = 0; i < 19; ++i) { rawn[i] = 0u; if (cact) { const int lr = 16 * kq - 3 + i; rawn[i] = (seg == 0 && lr < 0) ? 0u : *(const unsigned*)(PROJ + (size_t)(rseg + lr) * NPROJ + pcol); } }
    if (w == 7) dtrn = ((const float*)(a.ws + WS_SMALL))[(size_t)(rseg + lane) * 16 + 8 + h];
    for (int ch = 0; ch < 8; ++ch) {
        const int rowc = rseg + ch * 64;
#pragma unroll
        for (int i = 0; i < 19; ++i) raw[i] = rawn[i];
        dtr = dtrn;
        if (ch + 1 < 8) {
            if (cact) {
#pragma unroll
                for (int i = 0; i < 19; ++i) rawn[i] = *(const unsigned*)(PROJ + (size_t)(rowc + 64 + 16 * kq - 3 + i) * NPROJ + pcol);
            }
            if (w == 7) dtrn = ((const float*)(a.ws + WS_SMALL))[(size_t)(rowc + 64 + lane) * 16 + 8 + h];
        }
        if (w == 7) {
            const float dtv = softplus_f(dtr + dtb);
            const float ac = wave_incl_scan(dtv * negA, lane);
            dt_s[lane] = dtv; ac_s[lane] = ac;
        }
        GDN_BAR();
        if (cact) {
            const float al = ac_s[63];
            float y0[16], y1[16];
#pragma unroll
            for (int i = 0; i < 16; ++i) {
                float a0 = cw0[0] * bflo(raw[i]) + cw0[1] * bflo(raw[i + 1]) + cw0[2] * bflo(raw[i + 2]) + cw0[3] * bflo(raw[i + 3]) + cb0;
                float a1 = cw1[0] * bfhi(raw[i]) + cw1[1] * bfhi(raw[i + 1]) + cw1[2] * bfhi(raw[i + 2]) + cw1[3] * bfhi(raw[i + 3]) + cb1;
                a0 = silu_f(a0); a1 = silu_f(a1);
                if (isx) { const int r = 16 * kq + i; const float sc = dt_s[r] * __expf(al - ac_s[r]); a0 *= sc; a1 *= sc; }
                y0[i] = a0; y1[i] = a1;
            }
            LAS bf16_t* T = isx ? XTs + col2 * 72 : BTs + (col2 - 64) * 72;
#pragma unroll
            for (int i = 0; i < 16; i += 8) {
                *(LAS u32x4*)(T + 16 * kq + i) = (u32x4){pk2(y0[i], y0[i + 1]), pk2(y0[i + 2], y0[i + 3]), pk2(y0[i + 4], y0[i + 5]), pk2(y0[i + 6], y0[i + 7])};
                *(LAS u32x4*)(T + 72 + 16 * kq + i) = (u32x4){pk2(y1[i], y1[i + 1]), pk2(y1[i + 2], y1[i + 3]), pk2(y1[i + 4], y1[i + 5]), pk2(y1[i + 6], y1[i + 7])}; }
        }
        GDN_BAR();
        {
            const float dc = __expf(ac_s[63]);
            ltot += ac_s[63];
#pragma unroll
            for (int pj = 0; pj < 4; ++pj) {
                ST[pj] = ST[pj] * dc;
#pragma unroll
                for (int s2 = 0; s2 < 2; ++s2) ST[pj] = MFMA16(ldfrag(BTs, 72, 16 * w + fr, 32 * s2 + 8 * q), ldfrag(XTs, 72, 16 * pj + fr, 32 * s2 + 8 * q), ST[pj]);
            }
        }
        GDN_BAR();
    }
    float* SS = (float*)(a.ws + WS_SSEG) + (size_t)unit * 8192;
#pragma unroll
    for (int pj = 0; pj < 4; ++pj)
#pragma unroll
        for (int r = 0; r < 4; ++r) SS[(16 * w + 4 * q + r) * 64 + 16 * pj + fr] = ST[pj][r];
    if (tid == 0) ((float*)(a.ws + WS_LSEG))[unit] = ltot;
}

DI void ssd_pass_c(const Ctx& F, const Args& a, int l, int unit) {
    const int seg = unit & 15, g = (unit >> 4) & 1, b = unit >> 5;
    const int w = F.wave, lane = F.lane, tid = F.tid, fr = lane & 15, q = lane >> 4, hd = w >> 1, e2 = w & 1, head = g * 4 + hd;
    bf16_t* PROJ = (bf16_t*)(a.ws + WS_PROJ);
    LAS bf16_t* Cs = (LAS bf16_t*)F.lds;
    LAS bf16_t* Bs = (LAS bf16_t*)(F.lds + 17408);
    LAS bf16_t* BTs = (LAS bf16_t*)(F.lds + 34816);
    LAS bf16_t* XTs = (LAS bf16_t*)(F.lds + 53248);
    LAS float* CBs = (LAS float*)(F.lds + 90112);
    LAS float* dt_s = (LAS float*)(F.lds + 107520);
    LAS float* ac_s = (LAS float*)(F.lds + 108544);
    LAS float* rss = (LAS float*)(F.lds + 109568);
    f32x4 ST[8][2];
#pragma unroll
    for (int si = 0; si < 8; ++si)
#pragma unroll
        for (int pl = 0; pl < 2; ++pl) ST[si][pl] = (f32x4){0.f, 0.f, 0.f, 0.f};
    for (int j = 0; j < seg; ++j) {
        const int ua = (b * 16 + j) * 8 + head;
        const float dcj = __expf(((const float*)(a.ws + WS_LSEG))[ua]);
        const float* SS = (const float*)(a.ws + WS_SSEG) + (size_t)ua * 8192;
#pragma unroll
        for (int si = 0; si < 8; ++si)
#pragma unroll
            for (int pl = 0; pl < 2; ++pl)
#pragma unroll
                for (int r = 0; r < 4; ++r) ST[si][pl][r] = ST[si][pl][r] * dcj + SS[(16 * si + 4 * q + r) * 64 + 16 * (2 * e2 + pl) + fr];
    }
    const int cp = tid & 255, kq = tid >> 8, col2 = 2 * cp; const int ctype = col2 < 256 ? 0 : (col2 < 384 ? 1 : 2);
    const int pcol = ctype == 0 ? PC_SX + g * 256 + col2 : (ctype == 1 ? PC_BM + g * 128 + (col2 - 256) : PC_CM + g * 128 + (col2 - 384));
    const int cch = ctype == 0 ? g * 256 + col2 : (ctype == 1 ? 512 + g * 128 + (col2 - 256) : 768 + g * 128 + (col2 - 384));
    float cw0[4], cw1[4];
#pragma unroll
    for (int k = 0; k < 4; ++k) { cw0[k] = a.in[10][(size_t)(l * 4 + k) * 1024 + cch]; cw1[k] = a.in[10][(size_t)(l * 4 + k) * 1024 + cch + 1]; }
    const float cb0 = a.in[11][l * 1024 + cch], cb1 = a.in[11][l * 1024 + cch + 1];
    const int rseg = b * SEQ + seg * 512;
    const float dskip = a.in[14][l * 8 + head];
    float nwv[2]; nwv[0] = a.in[15][l * 512 + g * 256 + hd * 64 + 16 * (2 * e2) + fr]; nwv[1] = a.in[15][l * 512 + g * 256 + hd * 64 + 16 * (2 * e2 + 1) + fr];
    for (int ch = 0; ch < 8; ++ch) {
        const int rowc = rseg + ch * 64;
        if (w < 4) {
            const int hw = g * 4 + w;
            const float dtv = softplus_f(((const float*)(a.ws + WS_SMALL))[(size_t)(rowc + lane) * 16 + 8 + hw] + a.in[13][l * 8 + hw]);
            const float ac = wave_incl_scan(dtv * (-__expf(a.in[12][l * 8 + hw])), lane);
            dt_s[w * 64 + lane] = dtv; ac_s[w * 64 + lane] = ac;
        }
        {
            unsigned raw[35];
#pragma unroll
            for (int i = 0; i < 35; ++i) { const int lr = 32 * kq - 3 + i; raw[i] = (seg == 0 && ch == 0 && lr < 0) ? 0u : *(const unsigned*)(PROJ + (size_t)(rowc + lr) * NPROJ + pcol); }
            float yp0 = 0.f, yp1 = 0.f; unsigned t0[16], t1[16];
#pragma unroll
            for (int i = 0; i < 32; ++i) {
                float a0 = cw0[0] * bflo(raw[i]) + cw0[1] * bflo(raw[i + 1]) + cw0[2] * bflo(raw[i + 2]) + cw0[3] * bflo(raw[i + 3]) + cb0;
                float a1 = cw1[0] * bfhi(raw[i]) + cw1[1] * bfhi(raw[i + 1]) + cw1[2] * bfhi(raw[i + 2]) + cw1[3] * bfhi(raw[i + 3]) + cb1;
                a0 = silu_f(a0); a1 = silu_f(a1);
                const int r = 32 * kq + i;
                if (ctype == 1) *(LAS unsigned*)(Bs + r * 136 + (col2 - 256)) = pk2(a0, a1);
                if (ctype == 2) *(LAS unsigned*)(Cs + r * 136 + (col2 - 384)) = pk2(a0, a1);
                if (i & 1) { t0[i >> 1] = pk2(yp0, a0); t1[i >> 1] = pk2(yp1, a1); }
                yp0 = a0; yp1 = a1;
            }
            if (ctype < 2) { LAS bf16_t* T = ctype == 0 ? XTs + col2 * 72 : BTs + (col2 - 256) * 72;
#pragma unroll
                for (int v = 0; v < 4; ++v) { *(LAS u32x4*)(T + 32 * kq + 8 * v) = (u32x4){t0[4 * v], t0[4 * v + 1], t0[4 * v + 2], t0[4 * v + 3]}; *(LAS u32x4*)(T + 72 + 32 * kq + 8 * v) = (u32x4){t1[4 * v], t1[4 * v + 1], t1[4 * v + 2], t1[4 * v + 3]}; } }
        }
        GDN_BAR();
        {
            const int ci = w >> 1;
#pragma unroll
            for (int ee = 0; ee < 2; ++ee) {
                const int ej = 2 * (w & 1) + ee; f32x4 acc = {0.f, 0.f, 0.f, 0.f};
#pragma unroll
                for (int s = 0; s < 4; ++s) acc = MFMA16(ldfrag(Bs, 136, 16 * ej + fr, 32 * s + 8 * q), ldfrag(Cs, 136, 16 * ci + fr, 32 * s + 8 * q), acc);
                *(LAS f32x4*)(CBs + (16 * ci + fr) * 68 + 16 * ej + 4 * q) = acc;
            }
        }
        f32x4 Y[4][2];
        {
            bf16x8 STb[2][4];
#pragma unroll
            for (int pl = 0; pl < 2; ++pl)
#pragma unroll
                for (int s4 = 0; s4 < 4; ++s4) STb[pl][s4] = pack8(ST[2 * s4][pl][0], ST[2 * s4][pl][1], ST[2 * s4][pl][2], ST[2 * s4][pl][3], ST[2 * s4 + 1][pl][0], ST[2 * s4 + 1][pl][1], ST[2 * s4 + 1][pl][2], ST[2 * s4 + 1][pl][3]);
#pragma unroll
            for (int ci = 0; ci < 4; ++ci)
#pragma unroll
                for (int pl = 0; pl < 2; ++pl) {
                    f32x4 acc = {0.f, 0.f, 0.f, 0.f};
#pragma unroll
                    for (int s4 = 0; s4 < 4; ++s4) acc = MFMA16(ldfrag_perm16(Cs, 136, 16 * ci + fr, s4, q), STb[pl][s4], acc);
#pragma unroll
                    for (int r = 0; r < 4; ++r) acc[r] *= __expf(ac_s[hd * 64 + 16 * ci + 4 * q + r]);
                    Y[ci][pl] = acc;
                }
        }
        GDN_BAR();
        {
            const LAS float* ach = ac_s + hd * 64; const LAS float* dth = dt_s + hd * 64;
#pragma unroll
            for (int ci = 0; ci < 4; ++ci) {
                asm volatile("" ::: "memory");
                const int cc = 16 * ci + fr; const float acc_c = ach[cc];
#pragma unroll
                for (int s2 = 0; s2 < 2; ++s2) {
                    const int e0 = 32 * s2 + 8 * q; float gv[8];
                    const f32x4 c0 = *(const LAS f32x4*)(CBs + cc * 68 + e0), c1 = *(const LAS f32x4*)(CBs + cc * 68 + e0 + 4);
#pragma unroll
                    for (int j = 0; j < 8; ++j) { const int e = e0 + j; const float cbv = j < 4 ? c0[j & 3] : c1[j & 3]; gv[j] = (e <= cc) ? cbv * __expf(acc_c - ach[e]) * dth[e] : 0.f; }
                    const bf16x8 Gf = pack8(gv[0], gv[1], gv[2], gv[3], gv[4], gv[5], gv[6], gv[7]);
#pragma unroll
                    for (int pl = 0; pl < 2; ++pl) Y[ci][pl] = MFMA16(Gf, ldfrag(XTs, 72, hd * 64 + 16 * (2 * e2 + pl) + fr, e0), Y[ci][pl]);
                }
            }
            const float al = ach[63], dc = __expf(al);
            float scv[2][8];
#pragma unroll
            for (int s2 = 0; s2 < 2; ++s2)
#pragma unroll
                for (int j = 0; j < 8; ++j) { const int cidx = 32 * s2 + 8 * q + j; scv[s2][j] = dth[cidx] * __expf(al - ach[cidx]); }
#pragma unroll
            for (int si = 0; si < 8; ++si) {
                asm volatile("" ::: "memory");
                ST[si][0] = ST[si][0] * dc; ST[si][1] = ST[si][1] * dc;
#pragma unroll
                for (int s2 = 0; s2 < 2; ++s2) {
                    const u32x4 bv = *(const LAS u32x4*)(BTs + (16 * si + fr) * 72 + 32 * s2 + 8 * q);
                    const bf16x8 Bf = pack8(bflo(bv.x) * scv[s2][0], bfhi(bv.x) * scv[s2][1], bflo(bv.y) * scv[s2][2], bfhi(bv.y) * scv[s2][3], bflo(bv.z) * scv[s2][4], bfhi(bv.z) * scv[s2][5], bflo(bv.w) * scv[s2][6], bfhi(bv.w) * scv[s2][7]);
#pragma unroll
                    for (int pl = 0; pl < 2; ++pl) ST[si][pl] = MFMA16(Bf, ldfrag(XTs, 72, hd * 64 + 16 * (2 * e2 + pl) + fr, 32 * s2 + 8 * q), ST[si][pl]);
                }
            }
        }
        {
            float part[4][4];
#pragma unroll
            for (int ci = 0; ci < 4; ++ci)
#pragma unroll
                for (int r = 0; r < 4; ++r) {
                    const int cc = 16 * ci + 4 * q + r; float ps = 0.f;
#pragma unroll
                    for (int pl = 0; pl < 2; ++pl) {
                        const int p = 16 * (2 * e2 + pl) + fr;
                        const float x = bf2f(XTs[(hd * 64 + p) * 72 + cc]);
                        const float z = bf2f(PROJ[(size_t)(rowc + cc) * NPROJ + PC_SZ + g * 256 + hd * 64 + p]);
                        const float gz = (Y[ci][pl][r] + dskip * x) * silu_f(z);
                        Y[ci][pl][r] = gz; ps += gz * gz;
                    }
                    ps += __shfl_xor(ps, 1); ps += __shfl_xor(ps, 2); ps += __shfl_xor(ps, 4); ps += __shfl_xor(ps, 8);
                    part[ci][r] = ps;
                }
            if (fr == 0) {
#pragma unroll
                for (int ci = 0; ci < 4; ++ci)
#pragma unroll
                    for (int r = 0; r < 4; ++r) rss[w * 64 + 16 * ci + 4 * q + r] = part[ci][r];
            }
            GDN_BAR();
#pragma unroll
            for (int ci = 0; ci < 4; ++ci)
#pragma unroll
                for (int r = 0; r < 4; ++r) {
                    const int cc = 16 * ci + 4 * q + r; float tot = 0.f;
#pragma unroll
                    for (int ww = 0; ww < 8; ++ww) tot += rss[ww * 64 + cc];
                    const float rstd = rsqrtf(tot * (1.f / 256.f) + 1e-6f);
#pragma unroll
                    for (int pl = 0; pl < 2; ++pl) {
                        const int p = 16 * (2 * e2 + pl) + fr;
                        PROJ[(size_t)(rowc + cc) * NPROJ + PC_SZ + g * 256 + hd * 64 + p] = (bf16_t)f2bf(Y[ci][pl][r] * rstd * nwv[pl]);
                    }
                }
        }
        GDN_BAR();
    }
}

template <bool FINAL>
DI void lru_pass(const Ctx& F, const Args& a, int l, int unit) {
    const int blk = unit & 7, seg = (unit >> 3) & 15, b = unit >> 7;
    const int w = F.wave, lane = F.lane, tid = F.tid, fr = lane & 15, q = lane >> 4;
    bf16_t* PROJ = (bf16_t*)(a.ws + WS_PROJ);
    LAS bf16_t* WAT = (LAS bf16_t*)F.lds;
    LAS bf16_t* WXT = (LAS bf16_t*)(F.lds + 9216);
    LAS bf16_t* XCs = (LAS bf16_t*)(F.lds + 18432);
    LAS float* XF = (LAS float*)(F.lds + 27648);
    LAS float* As = (LAS float*)(F.lds + 44288);
    LAS float* Us = (LAS float*)(F.lds + 60928);
    for (int e8 = tid; e8 < 4096; e8 += 512) {
        const int d = e8 >> 6, e = e8 & 63;
        WAT[e * 72 + d] = (bf16_t)f2bf(a.in[18][((size_t)(l * 8 + blk) * 64 + d) * 64 + e]);
        WXT[e * 72 + d] = (bf16_t)f2bf(a.in[20][((size_t)(l * 8 + blk) * 64 + d) * 64 + e]);
    }
    const int chn = blk * 64 + (tid & 63);
    const int rseg = b * SEQ + seg * 512;
    const int cp = tid & 31, kq = (tid >> 5) & 7, cc2 = blk * 64 + 2 * cp;
    float cw0[4], cw1[4];
#pragma unroll
    for (int k = 0; k < 4; ++k) { cw0[k] = a.in[16][(size_t)(l * 4 + k) * 512 + cc2]; cw1[k] = a.in[16][(size_t)(l * 4 + k) * 512 + cc2 + 1]; }
    const float cb0 = a.in[17][l * 512 + cc2], cb1 = a.in[17][l * 512 + cc2 + 1];
    float hcur = 0.f, pprod = 1.f;
    if (FINAL && w == 0) {
        for (int j = 0; j < seg; ++j) hcur = hcur * ((const float*)(a.ws + WS_LRUP))[(size_t)(b * 16 + j) * 512 + chn] + ((const float*)(a.ws + WS_LRUH))[(size_t)(b * 16 + j) * 512 + chn];
    }
    float ba[2], bx[2], spl[2];
#pragma unroll
    for (int ee = 0; ee < 2; ++ee) { const int ce = blk * 64 + 16 * (2 * (w >> 2) + ee) + fr; ba[ee] = a.in[19][l * 512 + ce]; bx[ee] = a.in[21][l * 512 + ce]; spl[ee] = softplus_f(-a.in[22][l * 512 + ce]); }
    __syncthreads();
    unsigned raw[11], rawn[11];
#pragma unroll
    for (int i = 0; i < 11; ++i) { rawn[i] = 0u; if (tid < 256) { const int lr = 8 * kq - 3 + i; rawn[i] = (seg == 0 && lr < 0) ? 0u : *(const unsigned*)(PROJ + (size_t)(rseg + lr) * NPROJ + PC_LX + cc2); } }
    for (int ch = 0; ch < 8; ++ch) {
        const int rowc = rseg + ch * 64;
#pragma unroll
        for (int i = 0; i < 11; ++i) raw[i] = rawn[i];
        if (ch + 1 < 8 && tid < 256) {
#pragma unroll
            for (int i = 0; i < 11; ++i) rawn[i] = *(const unsigned*)(PROJ + (size_t)(rowc + 64 + 8 * kq - 3 + i) * NPROJ + PC_LX + cc2);
        }
        u32x4 gpre = {0u, 0u, 0u, 0u};
        if (FINAL) gpre = *(const u32x4*)(PROJ + (size_t)(rowc + (tid >> 3)) * NPROJ + PC_LG + blk * 64 + (tid & 7) * 8);
        if (tid < 256) {
#pragma unroll
            for (int i = 0; i < 8; ++i) {
                const float a0 = cw0[0] * bflo(raw[i]) + cw0[1] * bflo(raw[i + 1]) + cw0[2] * bflo(raw[i + 2]) + cw0[3] * bflo(raw[i + 3]) + cb0;
                const float a1 = cw1[0] * bfhi(raw[i]) + cw1[1] * bfhi(raw[i + 1]) + cw1[2] * bfhi(raw[i + 2]) + cw1[3] * bfhi(raw[i + 3]) + cb1;
                const int r = 8 * kq + i;
                *(LAS unsigned*)(XCs + r * 72 + 2 * cp) = pk2(a0, a1); XF[r * 65 + 2 * cp] = a0; XF[r * 65 + 2 * cp + 1] = a1;
            }
        }
        GDN_BAR();
        {
            const int ci = w & 3;
#pragma unroll
            for (int ee = 0; ee < 2; ++ee) {
                const int ej = 2 * (w >> 2) + ee; f32x4 aa = {0.f, 0.f, 0.f, 0.f}, ax = {0.f, 0.f, 0.f, 0.f};
#pragma unroll
                for (int s = 0; s < 2; ++s) { const bf16x8 xf = ldfrag(XCs, 72, 16 * ci + fr, 32 * s + 8 * q);
                    aa = MFMA16(xf, ldfrag(WAT, 72, 16 * ej + fr, 32 * s + 8 * q), aa); ax = MFMA16(xf, ldfrag(WXT, 72, 16 * ej + fr, 32 * s + 8 * q), ax); }
#pragma unroll
                for (int r = 0; r < 4; ++r) {
                    const int cc = 16 * ci + 4 * q + r, e = 16 * ej + fr;
                    const float rg = sigmoid_f(aa[r] + ba[ee]), ig = sigmoid_f(ax[r] + bx[ee]);
                    const float la = -8.0f * rg * spl[ee];
                    As[cc * 65 + e] = __expf(la); Us[cc * 65 + e] = sqrtf(neg_expm1_small(2.0f * la)) * ig * XF[cc * 65 + e];
                }
            }
        }
        GDN_BAR();
        if (w == 0) {
            float av[64], uv[64];
#pragma clang loop unroll(full)
            for (int i = 0; i < 64; ++i) { av[i] = As[i * 65 + lane]; uv[i] = Us[i * 65 + lane]; }
            __builtin_amdgcn_sched_barrier(0);
#pragma clang loop unroll(full)
            for (int i = 0; i < 64; ++i) { hcur = av[i] * hcur + uv[i]; pprod *= av[i]; uv[i] = hcur; }
            if (FINAL) {
#pragma clang loop unroll(full)
                for (int i = 0; i < 64; ++i) As[i * 65 + lane] = uv[i];
            }
        }
        if (FINAL) {
            GDN_BAR();
            const int cc = tid >> 3, e8 = (tid & 7) * 8;
            bf16_t* gp = PROJ + (size_t)(rowc + cc) * NPROJ + PC_LG + blk * 64 + e8;
            const u32x4 gv = gpre; const unsigned gg[4] = {gv.x, gv.y, gv.z, gv.w}; unsigned oo[4];
#pragma unroll
            for (int j = 0; j < 4; ++j) oo[j] = pk2(As[cc * 65 + e8 + 2 * j] * gelu_tanh_f(bflo(gg[j])), As[cc * 65 + e8 + 2 * j + 1] * gelu_tanh_f(bfhi(gg[j])));
            *(u32x4*)gp = (u32x4){oo[0], oo[1], oo[2], oo[3]};
        }
        GDN_BAR();
    }
    if (!FINAL && w == 0) {
        ((float*)(a.ws + WS_LRUP))[(size_t)(b * 16 + seg) * 512 + chn] = pprod;
        ((float*)(a.ws + WS_LRUH))[(size_t)(b * 16 + seg) * 512 + chn] = hcur;
    }
}


__global__ void __launch_bounds__(512, 2) mega_fwd(Args args) {
    extern __shared__ __attribute__((aligned(16))) unsigned char lds_raw[];
    LAS unsigned char* const ldsp = (LAS unsigned char*)lds_raw;
#define F make_ctx(ldsp)
    const int lo = args.ph_lo, hi = args.ph_hi;
    unsigned char* ws = args.ws;
    float* MOD = (float*)(ws + WS_MOD);
    bf16_t* XN = (bf16_t*)(ws + WS_XN); bf16_t* PROJ = (bf16_t*)(ws + WS_PROJ); bf16_t* MERGED = (bf16_t*)(ws + WS_MERGED);
#define IN(k) (lo <= (k) && (k) < hi)
    LAS unsigned long long* prs = (LAS unsigned long long*)(ldsp + 163824);
    if (PROBE_A >= 0 && threadIdx.x == 0) { prs[0] = 0ull; prs[1] = 0ull; }
#define STAMP(id) do { if (PROBE_A >= 0 && ((id) == PROBE_A || (id) == PROBE_B) && blockIdx.x == PROBE_BLK && threadIdx.x == 0) { const unsigned long long t_ = __builtin_amdgcn_s_memrealtime(); if ((id) == PROBE_A) prs[1] = t_; if ((id) == PROBE_B) prs[0] += t_ - prs[1]; } } while (0)
    volatile LAS unsigned* xst = (volatile LAS unsigned*)(ldsp + 163808);
    if (threadIdx.x == 0) { xst[0] = 0u; xst[1] = 0u; }
    __syncthreads();
    XcdBarrier xbar; xbar.bar = (unsigned*)(ws + WS_BAR); xbar.x = 0; xbar.st = xst;
    if (hi - lo > 1) xbar = xcd_barrier_post((unsigned*)(ws + WS_BAR), xst);
    if (hi > 1000) { __threadfence(); cg::this_grid().sync(); }
#define SEAM(k) do { if (IN(k) && IN((k) + 1)) xcd_barrier(xbar); } while (0)
    STAMP(40);
    if (IN(0)) { for (int rep = 0; rep < REP_B; ++rep) phase_p0(F, args); }
    SEAM(0);
    STAMP(41);
#pragma unroll 1
    for (int l = 0; l < 2; ++l) {
        const int base = 1 + 9 * l;
        const float* modl = MOD + (size_t)l * 4 * 6144;
        const bf16_t* wl = (const bf16_t*)(ws + WS_W) + (size_t)l * WO_LAYER;
        const float* xcur = l == 0 ? args.in[0] : args.out;
        STAMP(0);
        if (IN(base + 0)) for (int rep = 0; rep < REP_B; ++rep) phase_norm<true>(F, xcur, args.in[4] + l * DM, modl, 0, 1024, XN, (const float*)(ws + WS_WSM) + (size_t)l * 16 * 1024, (float*)(ws + WS_SMALL));
        STAMP(1);
        SEAM(base + 0);
        STAMP(2);
        if (IN(base + 1)) for (int rep = 0; rep < REP_A; ++rep) {
            pg8::Gemm g{XN, wl + WO_IN, MTOK, NPROJ, DM, DM, DM}; pg8::StaticOrder S; S.init(MTOK, NPROJ, F.G, F.bid);
            pg8::EpiProj E{PROJ, (bf16_t*)(ws + WS_TAIL)};
            pg8::gemm_phase(F.lds, g, S, E);
        }
        STAMP(3);
        SEAM(base + 1);
        STAMP(4);
        if (IN(base + 2)) {
            for (int u = F.bid; u < 2048; u += F.G) { STAMP(24); gdn_prep_unit(F, args, l, u); STAMP(25); __syncthreads(); }
        }
        STAMP(5);
        SEAM(base + 2);
        STAMP(6);
        if (IN(base + 3)) {
            if (F.bid < 16) gdn_seq(F, args, l, F.bid, xbar);
            else {
                const int j = F.bid - 16, NJ = F.G - 16;
                for (int u = j; u < 1024; u += NJ) {
                    if (u < 512) { STAMP(20); ssd_pass_a(F, args, l, u); STAMP(21); } else { STAMP(22); lru_pass<false>(F, args, l, u - 512); STAMP(23); }
                    __syncthreads();
                }
                xcd_barrier(xbar);
                if (j < 128) { STAMP(26); ssd_pass_c(F, args, l, j); STAMP(27); __syncthreads(); lru_pass<true>(F, args, l, j); __syncthreads(); }
                else { for (int u = 128 + (j - 128); u < 512; u += NJ - 128) { STAMP(28); lru_pass<true>(F, args, l, u); STAMP(29); __syncthreads(); } }
                if (l == 0) convert_weights(F, args, 1, j * 8 + F.wave, NJ * 8);
            }
        }
        STAMP(7);
        SEAM(base + 3);
        STAMP(8);
        if (IN(base + 4)) for (int rep = 0; rep < REP_A; ++rep) {
            gdn_post(F, args, l);
            pg8::StaticOrder S; S.init(MTOK, DM, F.G, F.bid);
            { pg8::GateOrder GO{S}; pg8::Gemm g{XN, wl + WO_GATE, MTOK, 3 * DM, DM, DM, DM}; pg8::EpiGate E{PROJ}; pg8::gemm_phase(F.lds, g, GO, E); }
            xcd_barrier(xbar);
            { pg8::BranchOrder BO{S}; pg8::Gemm g{PROJ, wl + WO_BR, MTOK, DM, 512, NPROJ, 512}; pg8::EpiBranch E{PROJ, MERGED}; pg8::gemm_phase(F.lds, g, BO, E); }
        }
        STAMP(9);
        SEAM(base + 4);
        STAMP(10);
        if (IN(base + 5)) {
            pg8::Gemm g{MERGED, wl + WO_OUT, MTOK, DM, DM, DM, DM}; pg8::StaticOrder S; S.init(MTOK, DM, F.G, F.bid);
            pg8::EpiResid E{xcur, args.out, modl + 2048};
            pg8::gemm_phase(F.lds, g, S, E);
        }
        STAMP(11);
        SEAM(base + 5);
        STAMP(12);
        if (IN(base + 6)) for (int rep = 0; rep < REP_B; ++rep) phase_norm<false>(F, args.out, args.in[25] + l * DM, modl, 3072, 4096, XN, nullptr, nullptr);
        STAMP(13);
        SEAM(base + 6);
        STAMP(14);
        if (IN(base + 7)) for (int rep = 0; rep < REP_A; ++rep) {
            pg8::Gemm g{XN, wl + WO_UP, MTOK, DFF, DM, DM, DM}; pg8::StaticOrder S; S.init(MTOK, DFF, F.G, F.bid);
            pg8::EpiUp E{PROJ};
            pg8::gemm_phase(F.lds, g, S, E);
        }
        STAMP(15);
        SEAM(base + 7);
        STAMP(16);
        if (IN(base + 8)) {
            pg8::Gemm g{PROJ, wl + WO_DOWN, MTOK, DM, DFF, DFF, DFF}; pg8::StaticOrder S; S.init(MTOK, DM, F.G, F.bid);
            pg8::EpiResid E{args.out, args.out, modl + 5120};
            pg8::gemm_phase(F.lds, g, S, E);
        }
        STAMP(17);
        SEAM(base + 8);
        STAMP(18);
    }
    if (IN(19)) phase_final_norm(F, args.out, args.in[28]);
    if (PROBE_A >= 0 && blockIdx.x == PROBE_BLK && threadIdx.x == 0) { const unsigned long long te = __builtin_amdgcn_s_memrealtime(); const unsigned long long dd = PROBE_K * prs[0]; while (__builtin_amdgcn_s_memrealtime() - te < dd) __builtin_amdgcn_s_sleep(8); }
#undef IN
#undef SEAM
}

extern "C" void kernel_launch(void* const* d_in, const int* in_sizes, int n_in, void* d_out, int out_size, void* d_ws, size_t ws_size, hipStream_t stream) {
    static int grid = 0;
    if (grid == 0) {
        if (n_in != 29 || out_size != MTOK * DM || ws_size < WS_END) { fprintf(stderr, "kernel_launch: unexpected problem (n_in %d out %d ws %zu)\n", n_in, out_size, ws_size); grid = -1; return; }
        int dev = 0, cus = 0, per_cu = 0;
        hipGetDevice(&dev); hipDeviceGetAttribute(&cus, hipDeviceAttributeMultiprocessorCount, dev);
        if (hipFuncSetAttribute((const void*)mega_fwd, hipFuncAttributeMaxDynamicSharedMemorySize, LDS_BYTES) != hipSuccess) { fprintf(stderr, "kernel_launch: hipFuncSetAttribute failed\n"); grid = -1; return; }
        if (hipOccupancyMaxActiveBlocksPerMultiprocessor(&per_cu, (const void*)mega_fwd, 512, LDS_BYTES) != hipSuccess || per_cu < 1) { fprintf(stderr, "kernel_launch: occupancy query says %d\n", per_cu); per_cu = 1; }
        (void)hipGetLastError();
        grid = cus * per_cu;
    }
    if (grid < 0) return;
    Args a{};
    for (int i = 0; i < 29; ++i) a.in[i] = (const float*)d_in[i];
    a.out = (float*)d_out; a.ws = (unsigned char*)d_ws;
    (void)hipMemsetAsync((char*)d_ws + WS_BAR, 0, XCD_BAR_WORDS * 4, stream);
#if MK_SINGLE
    a.ph_lo = 0; a.ph_hi = 20;
    void* kargs[] = {&a};
    hipError_t e = hipLaunchCooperativeKernel((const void*)mega_fwd, dim3(grid), dim3(512), kargs, LDS_BYTES, stream);
    if (e != hipSuccess) fprintf(stderr, "cooperative launch failed: %s (grid %d)\n", hipGetErrorString(e), grid);
#else
    for (int p = 0; p < 20; ++p) {
        a.ph_lo = p; a.ph_hi = p + 1;
        hipLaunchKernelGGL(mega_fwd, dim3(grid), dim3(512), LDS_BYTES, stream, a);
    }
#endif
}
```
